# Optimizing an MI355X kernel written in HIP

```python
import math
import jax
import jax.numpy as jnp
from jax import lax
import numpy as np


D_MODEL = 1024
BATCH = 16
SEQ = 2048
DEPTH = 1
DEC_BATCH = 2
DEC_SEQ = 8192
PAST_LEN = 128

POOL_WINDOWS = (2, 4, 8, 16)
POOL_GROUPS = len(POOL_WINDOWS)
POOL_WIDTH = D_MODEL // 2
POOL_GROUP_DIM = POOL_WIDTH // POOL_GROUPS
N_HEADS = 8
QK_NOPE_DIM = 64
QK_ROPE_DIM = 32
QK_HEAD_DIM = QK_NOPE_DIM + QK_ROPE_DIM
V_HEAD_DIM = 64
Q_LORA_RANK = 256
KV_LORA_RANK = 128
ATTN_WIDTH = N_HEADS * V_HEAD_DIM
MIX_WIDTH = POOL_WIDTH + ATTN_WIDTH
IN_PROJ_WIDTH = POOL_WIDTH + Q_LORA_RANK + KV_LORA_RANK + QK_ROPE_DIM
Q_BLOCK = 128
ROPE_THETA = 10000.0
D_FF = 2816
CONV_WIDTH = 3
EPS = 1e-6

kernel_name = 'hymba_pool_mla_convffn_encoder'


def rms_norm(x, g):
    xf = x.astype(jnp.float32)
    y = xf * lax.rsqrt(jnp.mean(xf * xf, axis=-1, keepdims=True) + EPS)
    return (y * g.astype(jnp.float32)).astype(x.dtype)


def rope_tables(seq):
    inv_freq = ROPE_THETA ** (-jnp.arange(0, QK_ROPE_DIM, 2, dtype=jnp.float32) / QK_ROPE_DIM)
    ang = jnp.arange(seq, dtype=jnp.float32)[:, None] * inv_freq[None, :]
    return jnp.cos(ang), jnp.sin(ang)


def apply_rope(x, cos, sin):
    xf = x.astype(jnp.float32)
    x1, x2 = jnp.split(xf, 2, axis=-1)
    c = cos[:, None, :]
    s = sin[:, None, :]
    return jnp.concatenate([x1 * c - x2 * s, x2 * c + x1 * s], axis=-1).astype(x.dtype)


def pool_mixer(u, w_pool, pool_scale):
    B, S, _ = u.shape
    uf = u.astype(jnp.float32)
    cs = jnp.concatenate([jnp.zeros((B, 1, POOL_WIDTH), jnp.float32), jnp.cumsum(uf, axis=1)], axis=1)
    t = jnp.arange(S)
    outs = []
    for g, w in enumerate(POOL_WINDOWS):
        lo_c = g * POOL_GROUP_DIM
        hi_c = (g + 1) * POOL_GROUP_DIM
        lo = jnp.clip(t - w // 2, 0, S)
        hi = jnp.clip(t + w // 2, 0, S)
        csg = cs[:, :, lo_c:hi_c]
        window_sum = jnp.take(csg, hi, axis=1) - jnp.take(csg, lo, axis=1)
        count = (hi - lo).astype(jnp.float32)[None, :, None]
        outs.append(window_sum / count - uf[:, :, lo_c:hi_c])
    pooled = jnp.stack(outs, axis=2).astype(u.dtype)
    mixed = jnp.einsum('bsgc,gcd->bsgd', pooled, w_pool).reshape(B, S, POOL_WIDTH)
    return mixed * pool_scale


def mla(q_lat, kv_lat, k_rope_raw, q_norm_g, w_uq, kv_norm_g, w_ukv, cos, sin):
    B, S, _ = q_lat.shape
    q = jnp.einsum('bsr,rn->bsn', rms_norm(q_lat, q_norm_g), w_uq).reshape(B, S, N_HEADS, QK_HEAD_DIM)
    q_nope, q_rope = jnp.split(q, [QK_NOPE_DIM], axis=-1)
    q_rope = apply_rope(q_rope, cos, sin)
    kv = jnp.einsum('bsr,rn->bsn', rms_norm(kv_lat, kv_norm_g), w_ukv).reshape(B, S, N_HEADS, QK_NOPE_DIM + V_HEAD_DIM)
    k_nope, v = jnp.split(kv, [QK_NOPE_DIM], axis=-1)
    k_rope = apply_rope(k_rope_raw[:, :, None, :], cos, sin)
    q_full = jnp.concatenate([q_nope, q_rope], axis=-1)
    k_full = jnp.concatenate([k_nope, jnp.broadcast_to(k_rope, (B, S, N_HEADS, QK_ROPE_DIM))], axis=-1)
    scale = 1.0 / math.sqrt(QK_HEAD_DIM)
    n_blk = S // Q_BLOCK
    qb = q_full.reshape(B, n_blk, Q_BLOCK, N_HEADS, QK_HEAD_DIM).transpose(1, 0, 2, 3, 4)

    def attend(q_blk):
        s = jnp.einsum('bqhd,bkhd->bhqk', q_blk, k_full).astype(jnp.float32) * scale
        p = jax.nn.softmax(s, axis=-1).astype(v.dtype)
        return jnp.einsum('bhqk,bkhd->bqhd', p, v)

    o = lax.map(attend, qb)
    return o.transpose(1, 0, 2, 3, 4).reshape(B, S, ATTN_WIDTH)


def conv_ffn(h, w_up, conv_w, conv_b, w_down):
    S = h.shape[1]
    u = jnp.einsum('bsd,df->bsf', h, w_up)
    pad = CONV_WIDTH // 2
    up = jnp.pad(u, ((0, 0), (pad, pad), (0, 0)))
    c = conv_b
    for k in range(CONV_WIDTH):
        c = c + up[:, k:k + S] * conv_w[k]
    gate, val = jnp.split(c, 2, axis=-1)
    return jnp.einsum('bsf,fd->bsd', jax.nn.silu(gate) * val, w_down)


def encoder_forward(x, norm_mix_g, w_in, q_norm_g, w_uq, kv_norm_g, w_ukv, w_pool, pool_scale,
                    w_out, norm_ffn_g, w_up, conv_w, conv_b, w_down, final_norm_g):
    S = x.shape[1]
    cos, sin = rope_tables(S)
    for l in range(DEPTH):
        h = rms_norm(x, norm_mix_g[l])
        z = jnp.einsum('bsd,dn->bsn', h, w_in[l])
        u_pool, q_lat, kv_lat, k_rope_raw = jnp.split(
            z, [POOL_WIDTH, POOL_WIDTH + Q_LORA_RANK, POOL_WIDTH + Q_LORA_RANK + KV_LORA_RANK], axis=-1)
        y_pool = pool_mixer(u_pool, w_pool[l], pool_scale[l])
        y_attn = mla(q_lat, kv_lat, k_rope_raw, q_norm_g[l], w_uq[l], kv_norm_g[l], w_ukv[l], cos, sin)
        mixed = jnp.concatenate([y_pool, y_attn], axis=-1)
        x = x + jnp.einsum('bsm,md->bsd', mixed, w_out[l])
        h = rms_norm(x, norm_ffn_g[l])
        x = x + conv_ffn(h, w_up[l], conv_w[l], conv_b[l], w_down[l])
    return rms_norm(x, final_norm_g)


def setup_inputs(seed: int = 0) -> dict:
    key = jax.random.key(seed)
    ks = jax.random.split(key, 20)
    f32 = jnp.float32

    def normal(k, shape, scale):
        return jax.random.normal(k, shape, f32) * scale

    def gain(k, shape):
        return 1.0 + 0.02 * jax.random.normal(k, shape, f32)

    return {
        'x_prompt': normal(ks[0], (BATCH, SEQ, D_MODEL), 1.0),
        'x_sample': normal(ks[1], (DEC_BATCH, DEC_SEQ, D_MODEL), 1.0),
        'norm_mix_g': gain(ks[2], (DEPTH, D_MODEL)),
        'w_in': normal(ks[3], (DEPTH, D_MODEL, IN_PROJ_WIDTH), D_MODEL ** -0.5),
        'q_norm_g': gain(ks[4], (DEPTH, Q_LORA_RANK)),
        'w_uq': normal(ks[5], (DEPTH, Q_LORA_RANK, N_HEADS * QK_HEAD_DIM), Q_LORA_RANK ** -0.5),
        'kv_norm_g': gain(ks[6], (DEPTH, KV_LORA_RANK)),
        'w_ukv': normal(ks[7], (DEPTH, KV_LORA_RANK, N_HEADS * (QK_NOPE_DIM + V_HEAD_DIM)), KV_LORA_RANK ** -0.5),
        'w_pool': normal(ks[8], (DEPTH, POOL_GROUPS, POOL_GROUP_DIM, POOL_GROUP_DIM), POOL_GROUP_DIM ** -0.5),
        'pool_scale': gain(ks[9], (DEPTH, POOL_WIDTH)),
        'w_out': normal(ks[10], (DEPTH, MIX_WIDTH, D_MODEL), MIX_WIDTH ** -0.5),
        'norm_ffn_g': gain(ks[11], (DEPTH, D_MODEL)),
        'w_up': normal(ks[12], (DEPTH, D_MODEL, 2 * D_FF), D_MODEL ** -0.5),
        'conv_w': normal(ks[13], (DEPTH, CONV_WIDTH, 2 * D_FF), CONV_WIDTH ** -0.5),
        'conv_b': normal(ks[14], (DEPTH, 2 * D_FF), 0.02),
        'w_down': normal(ks[15], (DEPTH, D_FF, D_MODEL), D_FF ** -0.5),
        'final_norm_g': gain(ks[16], (D_MODEL,)),
    }


def reference(x_prompt, x_sample, norm_mix_g, w_in, q_norm_g, w_uq, kv_norm_g, w_ukv, w_pool, pool_scale,
              w_out, norm_ffn_g, w_up, conv_w, conv_b, w_down, final_norm_g):
    y_prompt = encoder_forward(x_prompt, norm_mix_g, w_in, q_norm_g, w_uq, kv_norm_g, w_ukv, w_pool, pool_scale,
                               w_out, norm_ffn_g, w_up, conv_w, conv_b, w_down, final_norm_g)
    y_sample = encoder_forward(x_sample, norm_mix_g, w_in, q_norm_g, w_uq, kv_norm_g, w_ukv, w_pool, pool_scale,
                               w_out, norm_ffn_g, w_up, conv_w, conv_b, w_down, final_norm_g)
    return (y_prompt, y_sample)
```

```cpp
#include <hip/hip_runtime.h>
#include <cstdio>
#include <cstdint>
#include <cmath>

#ifndef MK_N_LAUNCHES
#define MK_N_LAUNCHES 0
#endif

#define GAS __attribute__((address_space(1)))
#define LAS __attribute__((address_space(3)))
typedef unsigned short bf16;
typedef short bf16x8 __attribute__((ext_vector_type(8)));
typedef float f32x4 __attribute__((ext_vector_type(4)));
typedef float f32x16 __attribute__((ext_vector_type(16)));
typedef unsigned v4u __attribute__((ext_vector_type(4)));
typedef unsigned v2u __attribute__((ext_vector_type(2)));
typedef GAS unsigned gu32;

constexpr int DM = 1024, MP = 16 * 2048, MS = 2 * 8192, M = MP + MS;
constexpr int SP = 2048, SS = 8192;
constexpr int NZ = 1024;
constexpr int NH = 8, QKD = 96, VD = 64, NQ = NH * QKD  , NKV = NH * 128  ;
constexpr int DFF = 2816, NUP = 2 * DFF;
constexpr float EPS = 1e-6f;
constexpr float C2 = 0.10206207261596577f * 1.4426950408889634f;

constexpr size_t MiB = 1u << 20;
constexpr size_t WS_CTL = 0, CTL_ZERO_BYTES = 1 * MiB;
constexpr size_t WS_WIN = 1 * MiB, WS_WOUT = 3 * MiB, WS_WUQ = 5 * MiB, WS_WUKV = 5 * MiB + 512 * 1024, WS_WPOOL = 6 * MiB, WS_WUP = 7 * MiB, WS_WDOWN = 18 * MiB;
constexpr size_t WS_COS = 23 * MiB + 512 * 1024, WS_SIN = WS_COS + 512 * 1024 / 2 * 2;
constexpr size_t WS_HB = 25 * MiB;
constexpr size_t WS_MIX = WS_HB;
constexpr size_t WS_Z = WS_HB + 96 * MiB;
constexpr size_t WS_H2 = WS_Z;
constexpr size_t WS_POOLED = WS_Z + 96 * MiB;
constexpr size_t WS_QN = WS_POOLED + 48 * MiB;
constexpr size_t WS_KVN = WS_QN + 24 * MiB;
constexpr size_t WS_Q = WS_KVN + 12 * MiB;
constexpr size_t WS_K = WS_Q + 72 * MiB;
constexpr size_t WS_V = WS_K + 72 * MiB;
constexpr size_t WS_ACT = WS_POOLED;
constexpr size_t WS_END = WS_V + 48 * MiB;
static_assert(WS_SIN + 512 * 1024 <= WS_HB, "tables");
static_assert(WS_ACT + (size_t)M * DFF * 2 <= WS_END, "ACT overlay");
static_assert(WS_END <= 512 * MiB, "workspace budget");

constexpr int CW_BAR = 4096;

__device__ __forceinline__ unsigned f2bf(float f) { unsigned u = __builtin_bit_cast(unsigned, f); return (u + 0x7fffu + ((u >> 16) & 1u)) >> 16; }
__device__ __forceinline__ unsigned pk2(float lo, float hi) { return f2bf(lo) | (f2bf(hi) << 16); }
__device__ __forceinline__ float bf2f(unsigned short b) { return __builtin_bit_cast(float, (unsigned)b << 16); }
__device__ __forceinline__ float wave_sum(float v) {
#pragma unroll
    for (int o = 1; o < 64; o <<= 1) v += __shfl_xor(v, o);
    return v;
}
#define LDS_WAIT() asm volatile("s_waitcnt lgkmcnt(0)" ::: "memory")
#define VM_WAIT() asm volatile("s_waitcnt vmcnt(0)" ::: "memory")

#define XB_TMO      128
#define XB_XCNT(j)  (256  + 64 * (j))
#define XB_XSUB(j)  (1280 + 64 * (j))
#define XB_XGEN(j)  (2304 + 64 * (j))
#define XB_TOP      3328
#define XB_TOPGEN   3392
#define XCD_BAR_WORDS 3456
#define XB_SPIN_CAP (1u << 22)
__device__ __forceinline__ unsigned xb_ld(unsigned* p)              { return __hip_atomic_load(p, __ATOMIC_RELAXED, __HIP_MEMORY_SCOPE_AGENT); }
__device__ __forceinline__ unsigned xb_add(unsigned* p, unsigned v) { return __hip_atomic_fetch_add(p, v, __ATOMIC_RELAXED, __HIP_MEMORY_SCOPE_AGENT); }
__device__ __forceinline__ unsigned xb_xcc_id() { return (unsigned)__builtin_amdgcn_s_getreg((3 << 11) | 20) & 0xFu; }
#define XB_SPIN(cond, bar) do { unsigned _sp = 0; while (cond) { __builtin_amdgcn_s_sleep(1); \
    if ((++_sp & 255u) == 0u) { if (xb_ld(&(bar)[XB_TMO])) break; if (_sp > XB_SPIN_CAP) { atomicAdd(&(bar)[XB_TMO], 1u); break; } } } } while (0)
struct XcdBarrier { unsigned* bar; unsigned x; volatile LAS unsigned* st; };
__device__ __forceinline__ XcdBarrier xcd_barrier_post(unsigned* bar, volatile LAS unsigned* st) {
    XcdBarrier b; b.bar = bar; b.x = xb_xcc_id(); b.st = st;
    if (threadIdx.x == 0) (void)xb_add(&bar[XB_XCNT(b.x)], 1u);
    return b;
}
__device__ __forceinline__ void xcd_barrier_complete(unsigned* bar, unsigned x, unsigned& nloc, unsigned& nx) {
    const unsigned G = gridDim.x * gridDim.y * gridDim.z;
    unsigned sum, cnt, mine, sp = 0u;
    for (;;) {
        sum = 0u; cnt = 0u; mine = 0u;
#pragma unroll
        for (unsigned j = 0; j < 16; ++j) { const unsigned c = xb_ld(&bar[XB_XCNT(j)]); sum += c; cnt += (c > 0u) ? 1u : 0u; mine = (j == x) ? c : mine; }
        if (sum == G) break;
        __builtin_amdgcn_s_sleep(1);
        if ((++sp & 255u) == 0u) { if (xb_ld(&bar[XB_TMO])) break; if (sp > XB_SPIN_CAP) { atomicAdd(&bar[XB_TMO], 1u); break; } }
    }
    nloc = mine > 0u ? mine : 1u; nx = cnt > 0u ? cnt : 1u;
}
__device__ __forceinline__ void xcd_barrier(const XcdBarrier& b) {
    asm volatile("s_waitcnt vmcnt(0)" ::: "memory");
    __syncthreads();
    if (threadIdx.x == 0) {
        unsigned* bar = b.bar;
        __builtin_amdgcn_s_waitcnt(0);
        unsigned nloc = b.st[0], nx = b.st[1];
        if (nloc == 0u) { xcd_barrier_complete(bar, b.x, nloc, nx); b.st[0] = nloc; b.st[1] = nx; }
        const unsigned old = xb_add(&bar[XB_XSUB(b.x)], 1u);
        const unsigned gen = old / nloc;
        if (old + 1u == (gen + 1u) * nloc) {
            __builtin_amdgcn_fence(__ATOMIC_RELEASE, "agent");
            asm volatile("s_waitcnt vmcnt(0)" ::: "memory");
            const unsigned og = xb_add(&bar[XB_TOP], 1u);
            const unsigned tg = og / nx;
            if (og + 1u == (tg + 1u) * nx) xb_add(&bar[XB_TOPGEN], 1u);
            else XB_SPIN(xb_ld(&bar[XB_TOPGEN]) == tg, bar);
            __builtin_amdgcn_fence(__ATOMIC_ACQUIRE, "agent");
            xb_add(&bar[XB_XGEN(b.x)], 1u);
            asm volatile("s_waitcnt vmcnt(0)" ::: "memory");
        } else {
            XB_SPIN(xb_ld(&bar[XB_XGEN(b.x)]) == gen, bar);
            __builtin_amdgcn_fence(__ATOMIC_ACQUIRE, "agent");
            asm volatile("s_waitcnt vmcnt(0)" ::: "memory");
        }
    }
    __syncthreads();
}

constexpr int NWAVES = 8;
constexpr int RING_BYTES = 139264;
constexpr int MISC_OFF = RING_BYTES;
constexpr int LDS_BYTES = 147456;

struct Args {
    const float* in[17]; float* out; unsigned char* ws;
    double freq_rev[16];
    int ph_lo, ph_hi;
};
struct Frame {
    LAS unsigned char* lds;
    int tid, lane, wave, gw, ngw, G;
    const float *xp, *xs, *g_mix, *w_in, *g_q, *w_uq, *g_kv, *w_ukv, *w_pool, *pool_scale, *w_out, *g_ffn, *w_up, *conv_w, *conv_b, *w_down, *g_final;
    float* out;
    bf16 *Win_t, *Wout_t, *Wuq_t, *Wukv_t, *Wpool_t, *Wup_t, *Wdown_t;
    float *COS, *SIN;
    bf16 *HB, *MIX, *Z, *H2, *POOLED, *QN, *KVN, *Q, *K, *V, *ACT;
};
__device__ __forceinline__ const float* xrow(const Frame& F, int m) { return m < MP ? F.xp + (size_t)m * DM : F.xs + (size_t)(m - MP) * DM; }
__device__ __forceinline__ void seqpos(int m, int& t, int& S, int& base) {
    if (m < MP) { S = SP; t = m & (SP - 1); base = m - t; } else { S = SS; t = (m - MP) & (SS - 1); base = m - t; }
}

__device__ __forceinline__ void transpose_item(const float* W, int K, int N, bf16* WT, int k0, int n0, int drow0, LAS float* scr, int lane) {
#pragma unroll 8
    for (int i = 0; i < 32; ++i) { const int kk = 2 * i + (lane >> 5); scr[kk * 33 + (lane & 31)] = W[(size_t)(k0 + kk) * N + n0 + (lane & 31)]; }
    LDS_WAIT(); asm volatile("" ::: "memory");
    const int c = lane & 7;
#pragma unroll
    for (int j = 0; j < 4; ++j) { const int n = (lane >> 3) + 8 * j; const LAS float* s = scr + (8 * c) * 33 + n;
        v4u o; o.x = pk2(s[0 * 33], s[1 * 33]); o.y = pk2(s[2 * 33], s[3 * 33]); o.z = pk2(s[4 * 33], s[5 * 33]); o.w = pk2(s[6 * 33], s[7 * 33]);
        *(GAS v4u*)(WT + (size_t)(drow0 + n) * K + k0 + 8 * c) = o; }
    LDS_WAIT(); asm volatile("" ::: "memory");
}
__device__ __forceinline__ void rms_row_to_bf16(const Frame& F, const float* xr_, const float* g, bf16* orow) {
    const GAS f32x4* xr = (const GAS f32x4*)xr_ + F.lane; const GAS f32x4* gr = (const GAS f32x4*)g + F.lane;
    f32x4 v[4]; float s = 0.f;
#pragma unroll
    for (int j = 0; j < 4; ++j) { v[j] = xr[64 * j]; s += (v[j].x * v[j].x + v[j].y * v[j].y) + (v[j].z * v[j].z + v[j].w * v[j].w); }
    const float rstd = 1.0f / sqrtf(wave_sum(s) * (1.f / DM) + EPS);
    GAS unsigned long long* o8 = (GAS unsigned long long*)orow + F.lane;
#pragma unroll
    for (int j = 0; j < 4; ++j) { const f32x4 gg = gr[64 * j];
        o8[64 * j] = (unsigned long long)pk2(v[j].x * rstd * gg.x, v[j].y * rstd * gg.y) | ((unsigned long long)pk2(v[j].z * rstd * gg.z, v[j].w * rstd * gg.w) << 32); }
}
__device__ __forceinline__ void p0_prologue(const Frame& F, const Args& args) {
    LAS float* scr = (LAS float*)(F.lds + F.wave * 16384);
    constexpr int I_IN = (1024 / 64) * (928 / 32), I_OUT = (1024 / 64) * (1024 / 32), I_UQ = (256 / 64) * (768 / 32), I_UKV = (128 / 64) * (1024 / 32),
                  I_UP = (1024 / 64) * (NUP / 32), I_DOWN = (DFF / 64) * (1024 / 32);
    constexpr int NITEMS = I_IN + I_OUT + I_UQ + I_UKV + I_UP + I_DOWN;
    for (int it = F.gw; it < NITEMS; it += F.ngw) {
        int r = it;
        if (r < I_IN) { const int nb = 928 / 32, kb = r / nb, n0 = (r % nb) * 32; transpose_item(F.w_in, 1024, 928, F.Win_t, kb * 64, n0, n0, scr, F.lane); continue; } r -= I_IN;
        if (r < I_OUT) { const int nb = 32, kb = r / nb, n0 = (r % nb) * 32; transpose_item(F.w_out, 1024, 1024, F.Wout_t, kb * 64, n0, n0, scr, F.lane); continue; } r -= I_OUT;
        if (r < I_UQ) { const int nb = 768 / 32, kb = r / nb, n0 = (r % nb) * 32; transpose_item(F.w_uq, 256, 768, F.Wuq_t, kb * 64, n0, n0, scr, F.lane); continue; } r -= I_UQ;
        if (r < I_UKV) { const int nb = 32, kb = r / nb, n0 = (r % nb) * 32; transpose_item(F.w_ukv, 128, 1024, F.Wukv_t, kb * 64, n0, n0, scr, F.lane); continue; } r -= I_UKV;
        if (r < I_UP) { const int nb = NUP / 32, kb = r / nb, n0 = (r % nb) * 32;
            const int f = n0 < DFF ? n0 : n0 - DFF; const int drow = 256 * (f / 128) + (n0 < DFF ? 0 : 128) + (f % 128);
            transpose_item(F.w_up, 1024, NUP, F.Wup_t, kb * 64, n0, drow, scr, F.lane); continue; } r -= I_UP;
        { const int nb = 32, kb = r / nb, n0 = (r % nb) * 32; transpose_item(F.w_down, DFF, 1024, F.Wdown_t, kb * 64, n0, n0, scr, F.lane); }
    }
    const int gt = F.gw * 64 + F.lane, ngt = F.ngw * 64;
    for (int i = gt; i < 96 * 1024 / 2; i += ngt) ((GAS unsigned*)(F.Win_t + 928 * 1024))[i] = 0u;
    for (int i = gt; i < 512 * 256; i += ngt) { const int n = i >> 8, k = i & 255; const int g = n >> 7, d = n & 127, pc = 256 * (n >> 8) + k, gp = pc >> 7;
        const float w = (gp == g) ? F.w_pool[((size_t)g * 128 + (pc & 127)) * 128 + d] : 0.f; F.Wpool_t[i] = (bf16)f2bf(w); }
    for (int i = gt; i < SS * 16; i += ngt) { const int t = i >> 4, j = i & 15; const double rev = (double)t * args.freq_rev[j]; const float fr = (float)(rev - floor(rev));
        F.COS[i] = __builtin_amdgcn_cosf(fr); F.SIN[i] = __builtin_amdgcn_sinf(fr); }
    for (int m = F.gw; m < M; m += F.ngw) rms_row_to_bf16(F, xrow(F, m), F.g_mix, F.HB + (size_t)m * DM);
}

template <class Epi>
__device__ __forceinline__ void sgemm(const Frame& F, const bf16* A, int lda, int a_noff, const bf16* Bt, int K, int Mr, int N, const Epi& E) {
    const int fr = F.lane & 15, fq = F.lane >> 4;
    const int tn = N / 64, tiles = (Mr / 64) * tn;
    for (int tile = F.gw; tile < tiles; tile += F.ngw) {
        const int r0 = (tile / tn) * 64, c0 = (tile % tn) * 64;
        f32x4 acc[4][4];
#pragma unroll
        for (int i = 0; i < 4; ++i)
#pragma unroll
            for (int j = 0; j < 4; ++j) acc[i][j] = (f32x4){0.f, 0.f, 0.f, 0.f};
        const bf16* Ab = A + (size_t)(r0 + fr) * lda + (c0 / 256) * a_noff + fq * 8;
        const bf16* Bb = Bt + (size_t)(c0 + fr) * K + fq * 8;
        for (int k0 = 0; k0 < K; k0 += 32) {
            bf16x8 a[4], b[4];
#pragma unroll
            for (int i = 0; i < 4; ++i) a[i] = *(const bf16x8*)(Ab + (size_t)i * 16 * lda + k0);
#pragma unroll
            for (int j = 0; j < 4; ++j) b[j] = *(const bf16x8*)(Bb + (size_t)j * 16 * K + k0);
#pragma unroll
            for (int i = 0; i < 4; ++i)
#pragma unroll
                for (int j = 0; j < 4; ++j) acc[i][j] = __builtin_amdgcn_mfma_f32_16x16x32_bf16(a[i], b[j], acc[i][j], 0, 0, 0);
        }
        E(acc, r0, c0, fr, fq);
    }
}
struct EpiZ { bf16* Z;
    __device__ __forceinline__ void operator()(const f32x4 (&acc)[4][4], int r0, int c0, int fr, int fq) const {
#pragma unroll
        for (int i = 0; i < 4; ++i)
#pragma unroll
            for (int r = 0; r < 4; ++r) { const size_t row = r0 + 16 * i + 4 * fq + r;
#pragma unroll
                for (int j = 0; j < 4; ++j) Z[row * NZ + c0 + 16 * j + fr] = (bf16)f2bf(acc[i][j][r]); } } };
struct EpiQ { bf16* Q; const float* COS; const float* SIN;
    __device__ __forceinline__ void operator()(const f32x4 (&acc)[4][4], int r0, int c0, int fr, int fq) const {
#pragma unroll
        for (int i = 0; i < 4; ++i)
#pragma unroll
            for (int r = 0; r < 4; ++r) { const int row = r0 + 16 * i + 4 * fq + r; int t, S, base; seqpos(row, t, S, base);
                const float cs = COS[t * 16 + fr], sn = SIN[t * 16 + fr];
#pragma unroll
                for (int j = 0; j < 4; ++j) { const int blk = ((c0 >> 4) + j) % 6; const size_t o = (size_t)row * NQ + c0 + 16 * j + fr;
                    if (blk < 4) Q[o] = (bf16)f2bf(acc[i][j][r] * C2);
                    else if (blk == 4) { if (j < 3) { const float x1 = acc[i][j][r], x2 = acc[i][j < 3 ? j + 1 : j][r];
                        Q[o] = (bf16)f2bf((x1 * cs - x2 * sn) * C2); Q[o + 16] = (bf16)f2bf((x2 * cs + x1 * sn) * C2); } } } } } };
struct EpiKV { bf16* K; bf16* V;
    __device__ __forceinline__ void operator()(const f32x4 (&acc)[4][4], int r0, int c0, int fr, int fq) const {
#pragma unroll
        for (int i = 0; i < 4; ++i)
#pragma unroll
            for (int r = 0; r < 4; ++r) { const size_t row = r0 + 16 * i + 4 * fq + r;
#pragma unroll
                for (int j = 0; j < 4; ++j) { const int col = c0 + 16 * j + fr, h = col >> 7, d = col & 127;
                    if (d < 64) K[row * NQ + h * QKD + d] = (bf16)f2bf(acc[i][j][r]); else V[row * 512 + h * VD + (d - 64)] = (bf16)f2bf(acc[i][j][r]); } } } };
struct EpiPool { bf16* MIX; const float* scale;
    __device__ __forceinline__ void operator()(const f32x4 (&acc)[4][4], int r0, int c0, int fr, int fq) const {
#pragma unroll
        for (int j = 0; j < 4; ++j) { const int col = c0 + 16 * j + fr; const float sc = scale[col];
#pragma unroll
            for (int i = 0; i < 4; ++i)
#pragma unroll
                for (int r = 0; r < 4; ++r) { const size_t row = r0 + 16 * i + 4 * fq + r; MIX[row * DM + col] = (bf16)f2bf(acc[i][j][r] * sc); } } } };
struct EpiWo { const float* xp; const float* xs; float* out;
    __device__ __forceinline__ void operator()(const f32x4 (&acc)[4][4], int r0, int c0, int fr, int fq) const {
        const float* xb = r0 < MP ? xp + (size_t)r0 * DM : xs + (size_t)(r0 - MP) * DM;
#pragma unroll
        for (int i = 0; i < 4; ++i)
#pragma unroll
            for (int r = 0; r < 4; ++r) { const size_t lr = 16 * i + 4 * fq + r;
#pragma unroll
                for (int j = 0; j < 4; ++j) { const int col = c0 + 16 * j + fr; out[(size_t)(r0 + lr) * DM + col] = xb[lr * DM + col] + acc[i][j][r]; } } } };
struct EpiDown { float* out;
    __device__ __forceinline__ void operator()(const f32x4 (&acc)[4][4], int r0, int c0, int fr, int fq) const {
#pragma unroll
        for (int i = 0; i < 4; ++i)
#pragma unroll
            for (int r = 0; r < 4; ++r) { const size_t row = r0 + 16 * i + 4 * fq + r;
#pragma unroll
                for (int j = 0; j < 4; ++j) { const int col = c0 + 16 * j + fr; out[row * DM + col] += acc[i][j][r]; } } } };

__device__ __forceinline__ void p2_rows(const Frame& F) {
    const int lane = F.lane;
    for (int m = F.gw; m < M; m += F.ngw) {
        int t, S, base; seqpos(m, t, S, base);
        const bf16* zr = F.Z + (size_t)m * NZ;
        { const v2u w = *(const GAS v2u*)(zr + 512 + 4 * lane); float v0 = bf2f(w.x & 0xffff), v1 = bf2f(w.x >> 16), v2 = bf2f(w.y & 0xffff), v3 = bf2f(w.y >> 16);
          const float rstd = 1.0f / sqrtf(wave_sum((v0 * v0 + v1 * v1) + (v2 * v2 + v3 * v3)) * (1.f / 256.f) + EPS);
          const f32x4 g = *(const GAS f32x4*)(F.g_q + 4 * lane);
          v2u o; o.x = pk2(v0 * rstd * g.x, v1 * rstd * g.y); o.y = pk2(v2 * rstd * g.z, v3 * rstd * g.w); *(GAS v2u*)(F.QN + (size_t)m * 256 + 4 * lane) = o; }
        { const unsigned w = *(const GAS unsigned*)(zr + 768 + 2 * lane); float v0 = bf2f(w & 0xffff), v1 = bf2f(w >> 16);
          const float rstd = 1.0f / sqrtf(wave_sum(v0 * v0 + v1 * v1) * (1.f / 128.f) + EPS);
          *(GAS unsigned*)(F.KVN + (size_t)m * 128 + 2 * lane) = pk2(v0 * rstd * F.g_kv[2 * lane], v1 * rstd * F.g_kv[2 * lane + 1]); }
        { const int i = lane & 15; const float x1 = bf2f(zr[896 + i]), x2 = bf2f(zr[912 + i]); const float cs = F.COS[t * 16 + i], sn = F.SIN[t * 16 + i];
          const float o = (lane & 16) ? (x2 * cs + x1 * sn) : (x1 * cs - x2 * sn);
          const unsigned short ob = (unsigned short)f2bf(o); const int d = lane & 31;
#pragma unroll
          for (int hh = 0; hh < 4; ++hh) { const int h = 2 * hh + (lane >> 5); F.K[(size_t)m * NQ + h * QKD + 64 + d] = ob; } }
        { const int g = lane >> 4, w = 2 << g; const int lo = (t - w / 2) < 0 ? 0 : t - w / 2, hi = (t + w / 2) > S ? S : t + w / 2;
          float s[8];
#pragma unroll
          for (int e = 0; e < 8; ++e) s[e] = 0.f;
          for (int tt = lo; tt < hi; ++tt) { const v4u u = *(const GAS v4u*)(F.Z + (size_t)(base + tt) * NZ + 8 * lane);
              s[0] += bf2f(u.x & 0xffff); s[1] += bf2f(u.x >> 16); s[2] += bf2f(u.y & 0xffff); s[3] += bf2f(u.y >> 16);
              s[4] += bf2f(u.z & 0xffff); s[5] += bf2f(u.z >> 16); s[6] += bf2f(u.w & 0xffff); s[7] += bf2f(u.w >> 16); }
          const float inv = 1.0f / (float)(hi - lo);
          const v4u u = *(const GAS v4u*)(zr + 8 * lane);
          v4u o; o.x = pk2(s[0] * inv - bf2f(u.x & 0xffff), s[1] * inv - bf2f(u.x >> 16)); o.y = pk2(s[2] * inv - bf2f(u.y & 0xffff), s[3] * inv - bf2f(u.y >> 16));
          o.z = pk2(s[4] * inv - bf2f(u.z & 0xffff), s[5] * inv - bf2f(u.z >> 16)); o.w = pk2(s[6] * inv - bf2f(u.w & 0xffff), s[7] * inv - bf2f(u.w >> 16));
          *(GAS v4u*)(F.POOLED + (size_t)m * 512 + 8 * lane) = o; }
    }
}

__device__ __forceinline__ int crow(int r, int hi) { return (r & 3) + 8 * (r >> 2) + 4 * hi; }
__device__ __forceinline__ void attn_simple(const Frame& F) {
    const int lane = F.lane, r32 = lane & 31, hi = lane >> 5;
    constexpr int UP_ = MP / 32 * NH, US_ = MS / 32 * NH;
    for (int u = F.gw; u < UP_ + US_; u += F.ngw) {
        int q0, h;
        if (u < US_) { h = u % NH; q0 = MP + (u / NH) * 32; } else { const int v = u - US_; h = v % NH; q0 = (v / NH) * 32; }
        int t, S, base; seqpos(q0, t, S, base);
        bf16x8 qf[6];
#pragma unroll
        for (int s = 0; s < 6; ++s) qf[s] = *(const bf16x8*)(F.Q + (size_t)(q0 + r32) * NQ + h * QKD + 16 * s + 8 * hi);
        f32x16 o0 = {}, o1 = {};
        float mrun = -1e30f, lrun = 0.f;
        for (int kv0 = 0; kv0 < S; kv0 += 32) {
            f32x16 x = {};
            const bf16* kp = F.K + (size_t)(base + kv0 + r32) * NQ + h * QKD + 8 * hi;
#pragma unroll
            for (int s = 0; s < 6; ++s) { const bf16x8 kf = *(const bf16x8*)(kp + 16 * s); x = __builtin_amdgcn_mfma_f32_32x32x16_bf16(kf, qf[s], x, 0, 0, 0); }
            float mx = x[0];
#pragma unroll
            for (int r = 1; r < 16; ++r) mx = fmaxf(mx, x[r]);
            mx = fmaxf(mx, __shfl_xor(mx, 32));
            const float mnew = fmaxf(mrun, mx), alpha = __builtin_amdgcn_exp2f(mrun - mnew);
            float ls = 0.f;
#pragma unroll
            for (int r = 0; r < 16; ++r) { x[r] = __builtin_amdgcn_exp2f(x[r] - mnew); ls += x[r]; }
            ls += __shfl_xor(ls, 32);
            lrun = lrun * alpha + ls; mrun = mnew;
#pragma unroll
            for (int r = 0; r < 16; ++r) { const float a = __shfl(alpha, crow(r, hi)); o0[r] *= a; o1[r] *= a; }
#pragma unroll
            for (int s = 0; s < 2; ++s) {
                bf16x8 pa;
#pragma unroll
                for (int j = 0; j < 8; ++j) pa[j] = (short)f2bf(x[8 * s + j]);
                bf16x8 v0, v1;
#pragma unroll
                for (int j = 0; j < 8; ++j) { const bf16* vp = F.V + (size_t)(base + kv0 + crow(8 * s + j, hi)) * 512 + h * VD + r32; v0[j] = (short)vp[0]; v1[j] = (short)vp[32]; }
                o0 = __builtin_amdgcn_mfma_f32_32x32x16_bf16(pa, v0, o0, 0, 0, 0);
                o1 = __builtin_amdgcn_mfma_f32_32x32x16_bf16(pa, v1, o1, 0, 0, 0);
            }
        }
        const float linv = 1.0f / lrun;
#pragma unroll
        for (int r = 0; r < 16; ++r) { const float li = __shfl(linv, crow(r, hi)); const size_t row = q0 + crow(r, hi);
            F.MIX[row * DM + 512 + h * VD + r32] = (bf16)f2bf(o0[r] * li); F.MIX[row * DM + 512 + h * VD + 32 + r32] = (bf16)f2bf(o1[r] * li); }
    }
}

__device__ __forceinline__ void up_simple(const Frame& F) {
    const int lane = F.lane, fr = lane & 15, fq = lane >> 4;
    LAS float* U = (LAS float*)(F.lds + F.wave * 16640);
    constexpr int RT_P = (SP + 61) / 62, RT_S = (SS + 61) / 62, NRT = 16 * RT_P + 2 * RT_S, NFT = DFF / 32;
    for (int tile = F.gw; tile < NRT * NFT; tile += F.ngw) {
        const int rt = tile / NFT, f0 = (tile % NFT) * 32;
        int base, S, R0;
        if (rt < 16 * RT_P) { base = (rt / RT_P) * SP; S = SP; R0 = (rt % RT_P) * 62; } else { const int q = rt - 16 * RT_P; base = MP + (q / RT_S) * SS; S = SS; R0 = (q % RT_S) * 62; }
        f32x4 acc[4][4];
#pragma unroll
        for (int i = 0; i < 4; ++i)
#pragma unroll
            for (int j = 0; j < 4; ++j) acc[i][j] = (f32x4){0.f, 0.f, 0.f, 0.f};
        const bf16* ap[4];
#pragma unroll
        for (int i = 0; i < 4; ++i) { int p = R0 - 1 + 16 * i + fr; p = p < 0 ? 0 : (p >= S ? S - 1 : p); ap[i] = F.H2 + (size_t)(base + p) * DM + fq * 8; }
        const bf16* bp[4];
#pragma unroll
        for (int j = 0; j < 4; ++j) { const int f = f0 + 16 * (j & 1) + fr; const int drow = 256 * (f / 128) + (j >> 1) * 128 + (f % 128); bp[j] = F.Wup_t + (size_t)drow * DM + fq * 8; }
        for (int k0 = 0; k0 < DM; k0 += 32) {
            bf16x8 a[4], b[4];
#pragma unroll
            for (int i = 0; i < 4; ++i) a[i] = *(const bf16x8*)(ap[i] + k0);
#pragma unroll
            for (int j = 0; j < 4; ++j) b[j] = *(const bf16x8*)(bp[j] + k0);
#pragma unroll
            for (int i = 0; i < 4; ++i)
#pragma unroll
                for (int j = 0; j < 4; ++j) acc[i][j] = __builtin_amdgcn_mfma_f32_16x16x32_bf16(a[i], b[j], acc[i][j], 0, 0, 0);
        }
#pragma unroll
        for (int i = 0; i < 4; ++i)
#pragma unroll
            for (int r = 0; r < 4; ++r) { const int lr = 16 * i + 4 * fq + r, p = R0 - 1 + lr; const bool ok = (p >= 0) && (p < S);
#pragma unroll
                for (int j = 0; j < 4; ++j) U[lr * 65 + 16 * j + fr] = ok ? acc[i][j][r] : 0.f; }
        LDS_WAIT(); asm volatile("" ::: "memory");
        const int c = lane & 31, f = f0 + c;
        const float bg = F.conv_b[f], bv = F.conv_b[DFF + f];
        const float g0 = F.conv_w[f], g1 = F.conv_w[NUP + f], g2 = F.conv_w[2 * NUP + f];
        const float w0 = F.conv_w[DFF + f], w1 = F.conv_w[NUP + DFF + f], w2 = F.conv_w[2 * NUP + DFF + f];
        for (int k = 0; k < 31; ++k) { const int lr = 1 + (lane >> 5) + 2 * k, p = R0 - 1 + lr;
            if (p < S) {
                const float cg = bg + g0 * U[(lr - 1) * 65 + c] + g1 * U[lr * 65 + c] + g2 * U[(lr + 1) * 65 + c];
                const float cv = bv + w0 * U[(lr - 1) * 65 + 32 + c] + w1 * U[lr * 65 + 32 + c] + w2 * U[(lr + 1) * 65 + 32 + c];
                const float act = cg / (1.0f + __expf(-cg)) * cv;
                F.ACT[(size_t)(base + p) * DFF + f] = (bf16)f2bf(act); } }
        LDS_WAIT(); asm volatile("" ::: "memory");
    }
}

constexpr int N_PHASES = 10;
__global__ void __launch_bounds__(NWAVES * 64, 2) mega_fwd(Args args) {
    extern __shared__ __attribute__((aligned(16))) unsigned char lds[];
    Frame F;
    F.lds = (LAS unsigned char*)lds;
    F.tid = threadIdx.x; F.lane = F.tid & 63; F.wave = __builtin_amdgcn_readfirstlane(F.tid >> 6);
    F.G = gridDim.x; F.gw = blockIdx.x * NWAVES + F.wave; F.ngw = F.G * NWAVES;
    F.xp = args.in[0]; F.xs = args.in[1]; F.g_mix = args.in[2]; F.w_in = args.in[3]; F.g_q = args.in[4]; F.w_uq = args.in[5]; F.g_kv = args.in[6]; F.w_ukv = args.in[7];
    F.w_pool = args.in[8]; F.pool_scale = args.in[9]; F.w_out = args.in[10]; F.g_ffn = args.in[11]; F.w_up = args.in[12]; F.conv_w = args.in[13]; F.conv_b = args.in[14];
    F.w_down = args.in[15]; F.g_final = args.in[16]; F.out = args.out;
    unsigned char* ws = args.ws;
    F.Win_t = (bf16*)(ws + WS_WIN); F.Wout_t = (bf16*)(ws + WS_WOUT); F.Wuq_t = (bf16*)(ws + WS_WUQ); F.Wukv_t = (bf16*)(ws + WS_WUKV); F.Wpool_t = (bf16*)(ws + WS_WPOOL);
    F.Wup_t = (bf16*)(ws + WS_WUP); F.Wdown_t = (bf16*)(ws + WS_WDOWN); F.COS = (float*)(ws + WS_COS); F.SIN = (float*)(ws + WS_SIN);
    F.HB = (bf16*)(ws + WS_HB); F.MIX = (bf16*)(ws + WS_MIX); F.Z = (bf16*)(ws + WS_Z); F.H2 = (bf16*)(ws + WS_H2); F.POOLED = (bf16*)(ws + WS_POOLED);
    F.QN = (bf16*)(ws + WS_QN); F.KVN = (bf16*)(ws + WS_KVN); F.Q = (bf16*)(ws + WS_Q); F.K = (bf16*)(ws + WS_K); F.V = (bf16*)(ws + WS_V); F.ACT = (bf16*)(ws + WS_ACT);
    volatile LAS unsigned* MISC = (volatile LAS unsigned*)(F.lds + MISC_OFF);
    for (int u = F.tid; u < (LDS_BYTES - MISC_OFF) / 4; u += NWAVES * 64) ((LAS unsigned*)(F.lds + MISC_OFF))[u] = 0u;
    __syncthreads();
    const int lo = args.ph_lo, hi = args.ph_hi;
    XcdBarrier bar; bar.bar = (unsigned*)(ws + WS_CTL) + CW_BAR; bar.x = 0; bar.st = nullptr;
    if (hi - lo > 1) bar = xcd_barrier_post((unsigned*)(ws + WS_CTL) + CW_BAR, MISC + 8);
#define IN(k) (lo <= (k) && (k) < hi)
#define SEAM(k) do { if (IN(k) && IN((k) + 1)) xcd_barrier(bar); } while (0)

    if (IN(0)) { p0_prologue(F, args); } SEAM(0);
    if (IN(1)) { EpiZ E{F.Z}; sgemm(F, F.HB, DM, 0, F.Win_t, DM, M, NZ, E); } SEAM(1);
    if (IN(2)) { p2_rows(F); } SEAM(2);
    if (IN(3)) {
        { EpiQ E{F.Q, F.COS, F.SIN}; sgemm(F, F.QN, 256, 0, F.Wuq_t, 256, M, NQ, E); }
        { EpiKV E{F.K, F.V}; sgemm(F, F.KVN, 128, 0, F.Wukv_t, 128, M, NKV, E); }
        { EpiPool E{F.MIX, F.pool_scale}; sgemm(F, F.POOLED, 512, 256, F.Wpool_t, 256, M, 512, E); }
    } SEAM(3);
    if (IN(4)) { attn_simple(F); } SEAM(4);
    if (IN(5)) { EpiWo E{F.xp, F.xs, F.out}; sgemm(F, F.MIX, DM, 0, F.Wout_t, DM, M, DM, E); } SEAM(5);
    if (IN(6)) { for (int m = F.gw; m < M; m += F.ngw) rms_row_to_bf16(F, F.out + (size_t)m * DM, F.g_ffn, F.H2 + (size_t)m * DM); } SEAM(6);
    if (IN(7)) { up_simple(F); } SEAM(7);
    if (IN(8)) { EpiDown E{F.out}; sgemm(F, F.ACT, DFF, 0, F.Wdown_t, DFF, M, DM, E); } SEAM(8);
    if (IN(9)) {
        for (int m = F.gw; m < M; m += F.ngw) {
            GAS f32x4* xr = (GAS f32x4*)(F.out + (size_t)m * DM) + F.lane; const GAS f32x4* gr = (const GAS f32x4*)F.g_final + F.lane;
            f32x4 v[4]; float s = 0.f;
#pragma unroll
            for (int j = 0; j < 4; ++j) { v[j] = xr[64 * j]; s += (v[j].x * v[j].x + v[j].y * v[j].y) + (v[j].z * v[j].z + v[j].w * v[j].w); }
            const float rstd = 1.0f / sqrtf(wave_sum(s) * (1.f / DM) + EPS);
#pragma unroll
            for (int j = 0; j < 4; ++j) xr[64 * j] = v[j] * rstd * gr[64 * j];
        }
    }
#undef IN
#undef SEAM
}

extern "C" void kernel_launch(void* const* d_in, const int* in_sizes, int n_in, void* d_out, int out_size, void* d_ws, size_t ws_size, hipStream_t stream) {
    static int grid = 0;
    if (grid == 0) {
        if (n_in != 17 || out_size != M * DM || ws_size < WS_END) { fprintf(stderr, "kernel_launch: unexpected shapes (n_in %d, out %d, ws %zu)\n", n_in, out_size, ws_size); grid = -1; return; }
        int dev = 0, cus = 0, per_cu = 0;
        if (hipGetDevice(&dev) != hipSuccess || hipDeviceGetAttribute(&cus, hipDeviceAttributeMultiprocessorCount, dev) != hipSuccess) { grid = -1; return; }
        if (hipFuncSetAttribute((const void*)mega_fwd, hipFuncAttributeMaxDynamicSharedMemorySize, LDS_BYTES) != hipSuccess) { fprintf(stderr, "kernel_launch: hipFuncSetAttribute failed\n"); grid = -1; return; }
        if (hipOccupancyMaxActiveBlocksPerMultiprocessor(&per_cu, (const void*)mega_fwd, NWAVES * 64, LDS_BYTES) != hipSuccess || per_cu < 1) { fprintf(stderr, "kernel_launch: occupancy query says %d\n", per_cu); per_cu = 1; }
        (void)hipGetLastError();
        grid = cus;
    }
    if (grid < 0) return;
    (void)hipMemsetAsync((char*)d_ws + WS_CTL, 0, CTL_ZERO_BYTES, stream);
    Args a{};
    for (int i = 0; i < 17; ++i) a.in[i] = (const float*)d_in[i];
    a.out = (float*)d_out; a.ws = (unsigned char*)d_ws;
    for (int i = 0; i < 16; ++i) a.freq_rev[i] = std::pow(10000.0, -(double)i / 16.0) / 6.283185307179586476925287;
#if MK_N_LAUNCHES == 1
    a.ph_lo = 0; a.ph_hi = N_PHASES;
    hipLaunchKernelGGL(mega_fwd, dim3(grid), dim3(NWAVES * 64), LDS_BYTES, stream, a);
#else
    for (int p = 0; p < N_PHASES; ++p) { a.ph_lo = p; a.ph_hi = p + 1; hipLaunchKernelGGL(mega_fwd, dim3(grid), dim3(NWAVES * 64), LDS_BYTES, stream, a); }
#endif
}
```

```cpp
#include <hip/hip_runtime.h>
#include <cstdio>
#include <cstdint>
#include <cmath>

#ifndef MK_N_LAUNCHES
#define MK_N_LAUNCHES 1
#endif

#define GAS __attribute__((address_space(1)))
#define LAS __attribute__((address_space(3)))
typedef unsigned short bf16;
typedef short bf16x8 __attribute__((ext_vector_type(8)));
typedef float f32x4 __attribute__((ext_vector_type(4)));
typedef float f32x16 __attribute__((ext_vector_type(16)));
typedef unsigned v4u __attribute__((ext_vector_type(4)));
typedef unsigned v2u __attribute__((ext_vector_type(2)));
typedef GAS unsigned gu32;

constexpr int DM = 1024, MP = 16 * 2048, MS = 2 * 8192, M = MP + MS;
constexpr int SP = 2048, SS = 8192;
constexpr int NZ = 1024;
constexpr int NH = 8, QKD = 96, VD = 64, NQ = NH * QKD  , NKV = NH * 128  ;
constexpr int DFF = 2816, NUP = 2 * DFF;
constexpr float EPS = 1e-6f;
constexpr float C2 = 0.10206207261596577f * 1.4426950408889634f;

constexpr size_t MiB = 1u << 20;
constexpr size_t WS_CTL = 0, CTL_ZERO_BYTES = 1 * MiB;
constexpr size_t WS_WIN = 1 * MiB, WS_WOUT = 3 * MiB, WS_WUQ = 5 * MiB, WS_WUKV = 5 * MiB + 512 * 1024, WS_WPOOL = 6 * MiB, WS_WUP = 7 * MiB, WS_WDOWN = 18 * MiB;
constexpr size_t WS_COS = 23 * MiB + 512 * 1024, WS_SIN = WS_COS + 512 * 1024 / 2 * 2;
constexpr size_t WS_HB = 25 * MiB;
constexpr size_t WS_MIX = WS_HB;
constexpr size_t WS_Z = WS_HB + 96 * MiB;
constexpr size_t WS_H2 = WS_Z;
constexpr size_t WS_POOLED = WS_Z + 96 * MiB;
constexpr size_t WS_QN = WS_POOLED + 48 * MiB;
constexpr size_t WS_KVN = WS_QN + 24 * MiB;
constexpr size_t WS_Q = WS_KVN + 12 * MiB;
constexpr size_t WS_K = WS_Q + 72 * MiB;
constexpr size_t WS_V = WS_K + 72 * MiB;
constexpr size_t WS_ACT = WS_POOLED;
constexpr size_t WS_END = WS_V + 48 * MiB;
static_assert(WS_SIN + 512 * 1024 <= WS_HB, "tables");
static_assert(WS_ACT + (size_t)M * DFF * 2 <= WS_END, "ACT overlay");
static_assert(WS_END <= 512 * MiB, "workspace budget");

constexpr int CW_BAR = 4096;

__device__ __forceinline__ unsigned f2bf(float f) { unsigned u = __builtin_bit_cast(unsigned, f); return (u + 0x7fffu + ((u >> 16) & 1u)) >> 16; }
__device__ __forceinline__ unsigned pk2(float lo, float hi) { return f2bf(lo) | (f2bf(hi) << 16); }
__device__ __forceinline__ float bf2f(unsigned short b) { return __builtin_bit_cast(float, (unsigned)b << 16); }
__device__ __forceinline__ float wave_sum(float v) {
#pragma unroll
    for (int o = 1; o < 64; o <<= 1) v += __shfl_xor(v, o);
    return v;
}
#define LDS_WAIT() asm volatile("s_waitcnt lgkmcnt(0)" ::: "memory")
#define VM_WAIT() asm volatile("s_waitcnt vmcnt(0)" ::: "memory")

#define XB_TMO      128
#define XB_XCNT(j)  (256  + 64 * (j))
#define XB_XSUB(j)  (1280 + 64 * (j))
#define XB_XGEN(j)  (2304 + 64 * (j))
#define XB_TOP      3328
#define XB_TOPGEN   3392
#define XCD_BAR_WORDS 3456
#define XB_SPIN_CAP (1u << 22)
__device__ __forceinline__ unsigned xb_ld(unsigned* p)              { return __hip_atomic_load(p, __ATOMIC_RELAXED, __HIP_MEMORY_SCOPE_AGENT); }
__device__ __forceinline__ unsigned xb_add(unsigned* p, unsigned v) { return __hip_atomic_fetch_add(p, v, __ATOMIC_RELAXED, __HIP_MEMORY_SCOPE_AGENT); }
__device__ __forceinline__ unsigned xb_xcc_id() { return (unsigned)__builtin_amdgcn_s_getreg((3 << 11) | 20) & 0xFu; }
#define XB_SPIN(cond, bar) do { unsigned _sp = 0; while (cond) { __builtin_amdgcn_s_sleep(1); \
    if ((++_sp & 255u) == 0u) { if (xb_ld(&(bar)[XB_TMO])) break; if (_sp > XB_SPIN_CAP) { atomicAdd(&(bar)[XB_TMO], 1u); break; } } } } while (0)
struct XcdBarrier { unsigned* bar; unsigned x; volatile LAS unsigned* st; };
__device__ __forceinline__ XcdBarrier xcd_barrier_post(unsigned* bar, volatile LAS unsigned* st) {
    XcdBarrier b; b.bar = bar; b.x = xb_xcc_id(); b.st = st;
    if (threadIdx.x == 0) (void)xb_add(&bar[XB_XCNT(b.x)], 1u);
    return b;
}
__device__ __forceinline__ void xcd_barrier_complete(unsigned* bar, unsigned x, unsigned& nloc, unsigned& nx) {
    const unsigned G = gridDim.x * gridDim.y * gridDim.z;
    unsigned sum, cnt, mine, sp = 0u;
    for (;;) {
        sum = 0u; cnt = 0u; mine = 0u;
#pragma unroll
        for (unsigned j = 0; j < 16; ++j) { const unsigned c = xb_ld(&bar[XB_XCNT(j)]); sum += c; cnt += (c > 0u) ? 1u : 0u; mine = (j == x) ? c : mine; }
        if (sum == G) break;
        __builtin_amdgcn_s_sleep(1);
        if ((++sp & 255u) == 0u) { if (xb_ld(&bar[XB_TMO])) break; if (sp > XB_SPIN_CAP) { atomicAdd(&bar[XB_TMO], 1u); break; } }
    }
    nloc = mine > 0u ? mine : 1u; nx = cnt > 0u ? cnt : 1u;
}
__device__ __forceinline__ void xcd_barrier(const XcdBarrier& b) {
    asm volatile("s_waitcnt vmcnt(0)" ::: "memory");
    __syncthreads();
    if (threadIdx.x == 0) {
        unsigned* bar = b.bar;
        __builtin_amdgcn_s_waitcnt(0);
        unsigned nloc = b.st[0], nx = b.st[1];
        if (nloc == 0u) { xcd_barrier_complete(bar, b.x, nloc, nx); b.st[0] = nloc; b.st[1] = nx; }
        const unsigned old = xb_add(&bar[XB_XSUB(b.x)], 1u);
        const unsigned gen = old / nloc;
        if (old + 1u == (gen + 1u) * nloc) {
            __builtin_amdgcn_fence(__ATOMIC_RELEASE, "agent");
            asm volatile("s_waitcnt vmcnt(0)" ::: "memory");
            const unsigned og = xb_add(&bar[XB_TOP], 1u);
            const unsigned tg = og / nx;
            if (og + 1u == (tg + 1u) * nx) xb_add(&bar[XB_TOPGEN], 1u);
            else XB_SPIN(xb_ld(&bar[XB_TOPGEN]) == tg, bar);
            __builtin_amdgcn_fence(__ATOMIC_ACQUIRE, "agent");
            xb_add(&bar[XB_XGEN(b.x)], 1u);
            asm volatile("s_waitcnt vmcnt(0)" ::: "memory");
        } else {
            XB_SPIN(xb_ld(&bar[XB_XGEN(b.x)]) == gen, bar);
            __builtin_amdgcn_fence(__ATOMIC_ACQUIRE, "agent");
            asm volatile("s_waitcnt vmcnt(0)" ::: "memory");
        }
    }
    __syncthreads();
}

constexpr int NWAVES = 8;
constexpr int RING_BYTES = 139264;
constexpr int MISC_OFF = RING_BYTES;
constexpr int LDS_BYTES = 147456;

struct Args {
    const float* in[17]; float* out; unsigned char* ws;
    double freq_rev[16];
    int ph_lo, ph_hi;
};
struct Frame {
    LAS unsigned char* lds;
    int tid, lane, wave, gw, ngw, G;
    const float *xp, *xs, *g_mix, *w_in, *g_q, *w_uq, *g_kv, *w_ukv, *w_pool, *pool_scale, *w_out, *g_ffn, *w_up, *conv_w, *conv_b, *w_down, *g_final;
    float* out;
    bf16 *Win_t, *Wout_t, *Wuq_t, *Wukv_t, *Wpool_t, *Wup_t, *Wdown_t;
    float *COS, *SIN;
    bf16 *HB, *MIX, *Z, *H2, *POOLED, *QN, *KVN, *Q, *K, *V, *ACT;
};
__device__ __forceinline__ const float* xrow(const Frame& F, int m) { return m < MP ? F.xp + (size_t)m * DM : F.xs + (size_t)(m - MP) * DM; }
__device__ __forceinline__ void seqpos(int m, int& t, int& S, int& base) {
    if (m < MP) { S = SP; t = m & (SP - 1); base = m - t; } else { S = SS; t = (m - MP) & (SS - 1); base = m - t; }
}

__device__ __forceinline__ void transpose_item(const float* W, int K, int N, bf16* WT, int k0, int n0, int drow0, LAS float* scr, int lane) {
#pragma unroll 8
    for (int i = 0; i < 32; ++i) { const int kk = 2 * i + (lane >> 5); scr[kk * 33 + (lane & 31)] = W[(size_t)(k0 + kk) * N + n0 + (lane & 31)]; }
    LDS_WAIT(); asm volatile("" ::: "memory");
    const int c = lane & 7;
#pragma unroll
    for (int j = 0; j < 4; ++j) { const int n = (lane >> 3) + 8 * j; const LAS float* s = scr + (8 * c) * 33 + n;
        v4u o; o.x = pk2(s[0 * 33], s[1 * 33]); o.y = pk2(s[2 * 33], s[3 * 33]); o.z = pk2(s[4 * 33], s[5 * 33]); o.w = pk2(s[6 * 33], s[7 * 33]);
        *(GAS v4u*)(WT + (size_t)(drow0 + n) * K + k0 + 8 * c) = o; }
    LDS_WAIT(); asm volatile("" ::: "memory");
}
__device__ __forceinline__ void rms_row_to_bf16(const Frame& F, const float* xr_, const float* g, bf16* orow) {
    const GAS f32x4* xr = (const GAS f32x4*)xr_ + F.lane; const GAS f32x4* gr = (const GAS f32x4*)g + F.lane;
    f32x4 v[4]; float s = 0.f;
#pragma unroll
    for (int j = 0; j < 4; ++j) { v[j] = xr[64 * j]; s += (v[j].x * v[j].x + v[j].y * v[j].y) + (v[j].z * v[j].z + v[j].w * v[j].w); }
    const float rstd = 1.0f / sqrtf(wave_sum(s) * (1.f / DM) + EPS);
    GAS unsigned long long* o8 = (GAS unsigned long long*)orow + F.lane;
#pragma unroll
    for (int j = 0; j < 4; ++j) { const f32x4 gg = gr[64 * j];
        o8[64 * j] = (unsigned long long)pk2(v[j].x * rstd * gg.x, v[j].y * rstd * gg.y) | ((unsigned long long)pk2(v[j].z * rstd * gg.z, v[j].w * rstd * gg.w) << 32); }
}
__device__ __forceinline__ void p0_prologue(const Frame& F, const Args& args) {
    LAS float* scr = (LAS float*)(F.lds + F.wave * 16384);
    constexpr int I_IN = (1024 / 64) * (928 / 32), I_OUT = (1024 / 64) * (1024 / 32), I_UQ = (256 / 64) * (768 / 32), I_UKV = (128 / 64) * (1024 / 32),
                  I_UP = (1024 / 64) * (NUP / 32), I_DOWN = (DFF / 64) * (1024 / 32);
    constexpr int NITEMS = I_IN + I_OUT + I_UQ + I_UKV + I_UP + I_DOWN;
    for (int it = F.gw; it < NITEMS; it += F.ngw) {
        int r = it;
        if (r < I_IN) { const int nb = 928 / 32, kb = r / nb, n0 = (r % nb) * 32; transpose_item(F.w_in, 1024, 928, F.Win_t, kb * 64, n0, n0, scr, F.lane); continue; } r -= I_IN;
        if (r < I_OUT) { const int nb = 32, kb = r / nb, n0 = (r % nb) * 32; transpose_item(F.w_out, 1024, 1024, F.Wout_t, kb * 64, n0, n0, scr, F.lane); continue; } r -= I_OUT;
        if (r < I_UQ) { const int nb = 768 / 32, kb = r / nb, n0 = (r % nb) * 32; transpose_item(F.w_uq, 256, 768, F.Wuq_t, kb * 64, n0, n0, scr, F.lane); continue; } r -= I_UQ;
        if (r < I_UKV) { const int nb = 32, kb = r / nb, n0 = (r % nb) * 32; transpose_item(F.w_ukv, 128, 1024, F.Wukv_t, kb * 64, n0, n0, scr, F.lane); continue; } r -= I_UKV;
        if (r < I_UP) { const int nb = NUP / 32, kb = r / nb, n0 = (r % nb) * 32;
            const int f = n0 < DFF ? n0 : n0 - DFF; const int drow = 256 * (f / 128) + (n0 < DFF ? 0 : 128) + (f % 128);
            transpose_item(F.w_up, 1024, NUP, F.Wup_t, kb * 64, n0, drow, scr, F.lane); continue; } r -= I_UP;
        { const int nb = 32, kb = r / nb, n0 = (r % nb) * 32; transpose_item(F.w_down, DFF, 1024, F.Wdown_t, kb * 64, n0, n0, scr, F.lane); }
    }
    const int gt = F.gw * 64 + F.lane, ngt = F.ngw * 64;
    for (int i = gt; i < 96 * 1024 / 2; i += ngt) ((GAS unsigned*)(F.Win_t + 928 * 1024))[i] = 0u;
    for (int i = gt; i < 512 * 256; i += ngt) { const int n = i >> 8, k = i & 255; const int g = n >> 7, d = n & 127, pc = 256 * (n >> 8) + k, gp = pc >> 7;
        const float w = (gp == g) ? F.w_pool[((size_t)g * 128 + (pc & 127)) * 128 + d] : 0.f; F.Wpool_t[i] = (bf16)f2bf(w); }
    for (int i = gt; i < SS * 16; i += ngt) { const int t = i >> 4, j = i & 15; const double rev = (double)t * args.freq_rev[j]; const float fr = (float)(rev - floor(rev));
        F.COS[i] = __builtin_amdgcn_cosf(fr); F.SIN[i] = __builtin_amdgcn_sinf(fr); }
    for (int m = F.gw; m < M; m += F.ngw) rms_row_to_bf16(F, xrow(F, m), F.g_mix, F.HB + (size_t)m * DM);
}

template <class Epi>
__device__ __forceinline__ void sgemm(const Frame& F, const bf16* A, int lda, int a_noff, const bf16* Bt, int K, int Mr, int N, const Epi& E) {
    const int fr = F.lane & 15, fq = F.lane >> 4;
    const int tn = N / 64, tiles = (Mr / 64) * tn;
    for (int tile = F.gw; tile < tiles; tile += F.ngw) {
        const int r0 = (tile / tn) * 64, c0 = (tile % tn) * 64;
        f32x4 acc[4][4];
#pragma unroll
        for (int i = 0; i < 4; ++i)
#pragma unroll
            for (int j = 0; j < 4; ++j) acc[i][j] = (f32x4){0.f, 0.f, 0.f, 0.f};
        const bf16* Ab = A + (size_t)(r0 + fr) * lda + (c0 / 256) * a_noff + fq * 8;
        const bf16* Bb = Bt + (size_t)(c0 + fr) * K + fq * 8;
        for (int k0 = 0; k0 < K; k0 += 32) {
            bf16x8 a[4], b[4];
#pragma unroll
            for (int i = 0; i < 4; ++i) a[i] = *(const bf16x8*)(Ab + (size_t)i * 16 * lda + k0);
#pragma unroll
            for (int j = 0; j < 4; ++j) b[j] = *(const bf16x8*)(Bb + (size_t)j * 16 * K + k0);
#pragma unroll
            for (int i = 0; i < 4; ++i)
#pragma unroll
                for (int j = 0; j < 4; ++j) acc[i][j] = __builtin_amdgcn_mfma_f32_16x16x32_bf16(a[i], b[j], acc[i][j], 0, 0, 0);
        }
        E(acc, r0, c0, fr, fq);
    }
}
struct EpiZ { bf16* Z;
    __device__ __forceinline__ void operator()(const f32x4 (&acc)[4][4], int r0, int c0, int fr, int fq) const {
#pragma unroll
        for (int i = 0; i < 4; ++i)
#pragma unroll
            for (int r = 0; r < 4; ++r) { const size_t row = r0 + 16 * i + 4 * fq + r;
#pragma unroll
                for (int j = 0; j < 4; ++j) Z[row * NZ + c0 + 16 * j + fr] = (bf16)f2bf(acc[i][j][r]); } } };
struct EpiQ { bf16* Q; const float* COS; const float* SIN;
    __device__ __forceinline__ void operator()(const f32x4 (&acc)[4][4], int r0, int c0, int fr, int fq) const {
#pragma unroll
        for (int i = 0; i < 4; ++i)
#pragma unroll
            for (int r = 0; r < 4; ++r) { const int row = r0 + 16 * i + 4 * fq + r; int t, S, base; seqpos(row, t, S, base);
                const float cs = COS[t * 16 + fr], sn = SIN[t * 16 + fr];
#pragma unroll
                for (int j = 0; j < 4; ++j) { const int blk = ((c0 >> 4) + j) % 6; const size_t o = (size_t)row * NQ + c0 + 16 * j + fr;
                    if (blk < 4) Q[o] = (bf16)f2bf(acc[i][j][r] * C2);
                    else if (blk == 4) { if (j < 3) { const float x1 = acc[i][j][r], x2 = acc[i][j < 3 ? j + 1 : j][r];
                        Q[o] = (bf16)f2bf((x1 * cs - x2 * sn) * C2); Q[o + 16] = (bf16)f2bf((x2 * cs + x1 * sn) * C2); } } } } } };
struct EpiKV { bf16* K; bf16* V;
    __device__ __forceinline__ void operator()(const f32x4 (&acc)[4][4], int r0, int c0, int fr, int fq) const {
#pragma unroll
        for (int i = 0; i < 4; ++i)
#pragma unroll
            for (int r = 0; r < 4; ++r) { const size_t row = r0 + 16 * i + 4 * fq + r;
#pragma unroll
                for (int j = 0; j < 4; ++j) { const int col = c0 + 16 * j + fr, h = col >> 7, d = col & 127;
                    if (d < 64) K[row * NQ + h * QKD + d] = (bf16)f2bf(acc[i][j][r]); else V[row * 512 + h * VD + (d - 64)] = (bf16)f2bf(acc[i][j][r]); } } } };
struct EpiPool { bf16* MIX; const float* scale;
    __device__ __forceinline__ void operator()(const f32x4 (&acc)[4][4], int r0, int c0, int fr, int fq) const {
#pragma unroll
        for (int j = 0; j < 4; ++j) { const int col = c0 + 16 * j + fr; const float sc = scale[col];
#pragma unroll
            for (int i = 0; i < 4; ++i)
#pragma unroll
                for (int r = 0; r < 4; ++r) { const size_t row = r0 + 16 * i + 4 * fq + r; MIX[row * DM + col] = (bf16)f2bf(acc[i][j][r] * sc); } } } };
struct EpiWo { const float* xp; const float* xs; float* out;
    __device__ __forceinline__ void operator()(const f32x4 (&acc)[4][4], int r0, int c0, int fr, int fq) const {
        const float* xb = r0 < MP ? xp + (size_t)r0 * DM : xs + (size_t)(r0 - MP) * DM;
#pragma unroll
        for (int i = 0; i < 4; ++i)
#pragma unroll
            for (int r = 0; r < 4; ++r) { const size_t lr = 16 * i + 4 * fq + r;
#pragma unroll
                for (int j = 0; j < 4; ++j) { const int col = c0 + 16 * j + fr; out[(size_t)(r0 + lr) * DM + col] = xb[lr * DM + col] + acc[i][j][r]; } } } };
struct EpiDown { float* out;
    __device__ __forceinline__ void operator()(const f32x4 (&acc)[4][4], int r0, int c0, int fr, int fq) const {
#pragma unroll
        for (int i = 0; i < 4; ++i)
#pragma unroll
            for (int r = 0; r < 4; ++r) { const size_t row = r0 + 16 * i + 4 * fq + r;
#pragma unroll
                for (int j = 0; j < 4; ++j) { const int col = c0 + 16 * j + fr; out[row * DM + col] += acc[i][j][r]; } } } };

__device__ __forceinline__ void p2_rows(const Frame& F) {
    const int lane = F.lane;
    for (int m = F.gw; m < M; m += F.ngw) {
        int t, S, base; seqpos(m, t, S, base);
        const bf16* zr = F.Z + (size_t)m * NZ;
        { const v2u w = *(const GAS v2u*)(zr + 512 + 4 * lane); float v0 = bf2f(w.x & 0xffff), v1 = bf2f(w.x >> 16), v2 = bf2f(w.y & 0xffff), v3 = bf2f(w.y >> 16);
          const float rstd = 1.0f / sqrtf(wave_sum((v0 * v0 + v1 * v1) + (v2 * v2 + v3 * v3)) * (1.f / 256.f) + EPS);
          const f32x4 g = *(const GAS f32x4*)(F.g_q + 4 * lane);
          v2u o; o.x = pk2(v0 * rstd * g.x, v1 * rstd * g.y); o.y = pk2(v2 * rstd * g.z, v3 * rstd * g.w); *(GAS v2u*)(F.QN + (size_t)m * 256 + 4 * lane) = o; }
        { const unsigned w = *(const GAS unsigned*)(zr + 768 + 2 * lane); float v0 = bf2f(w & 0xffff), v1 = bf2f(w >> 16);
          const float rstd = 1.0f / sqrtf(wave_sum(v0 * v0 + v1 * v1) * (1.f / 128.f) + EPS);
          *(GAS unsigned*)(F.KVN + (size_t)m * 128 + 2 * lane) = pk2(v0 * rstd * F.g_kv[2 * lane], v1 * rstd * F.g_kv[2 * lane + 1]); }
        { const int i = lane & 15; const float x1 = bf2f(zr[896 + i]), x2 = bf2f(zr[912 + i]); const float cs = F.COS[t * 16 + i], sn = F.SIN[t * 16 + i];
          const float o = (lane & 16) ? (x2 * cs + x1 * sn) : (x1 * cs - x2 * sn);
          const unsigned short ob = (unsigned short)f2bf(o); const int d = lane & 31;
#pragma unroll
          for (int hh = 0; hh < 4; ++hh) { const int h = 2 * hh + (lane >> 5); F.K[(size_t)m * NQ + h * QKD + 64 + d] = ob; } }
        { const int g = lane >> 4, w = 2 << g; const int lo = (t - w / 2) < 0 ? 0 : t - w / 2, hi = (t + w / 2) > S ? S : t + w / 2;
          float s[8];
#pragma unroll
          for (int e = 0; e < 8; ++e) s[e] = 0.f;
          for (int tt = lo; tt < hi; ++tt) { const v4u u = *(const GAS v4u*)(F.Z + (size_t)(base + tt) * NZ + 8 * lane);
              s[0] += bf2f(u.x & 0xffff); s[1] += bf2f(u.x >> 16); s[2] += bf2f(u.y & 0xffff); s[3] += bf2f(u.y >> 16);
              s[4] += bf2f(u.z & 0xffff); s[5] += bf2f(u.z >> 16); s[6] += bf2f(u.w & 0xffff); s[7] += bf2f(u.w >> 16); }
          const float inv = 1.0f / (float)(hi - lo);
          const v4u u = *(const GAS v4u*)(zr + 8 * lane);
          v4u o; o.x = pk2(s[0] * inv - bf2f(u.x & 0xffff), s[1] * inv - bf2f(u.x >> 16)); o.y = pk2(s[2] * inv - bf2f(u.y & 0xffff), s[3] * inv - bf2f(u.y >> 16));
          o.z = pk2(s[4] * inv - bf2f(u.z & 0xffff), s[5] * inv - bf2f(u.z >> 16)); o.w = pk2(s[6] * inv - bf2f(u.w & 0xffff), s[7] * inv - bf2f(u.w >> 16));
          *(GAS v4u*)(F.POOLED + (size_t)m * 512 + 8 * lane) = o; }
    }
}

__device__ __forceinline__ int crow(int r, int hi) { return (r & 3) + 8 * (r >> 2) + 4 * hi; }
__device__ __forceinline__ void attn_simple(const Frame& F) {
    const int lane = F.lane, r32 = lane & 31, hi = lane >> 5;
    constexpr int UP_ = MP / 32 * NH, US_ = MS / 32 * NH;
    for (int u = F.gw; u < UP_ + US_; u += F.ngw) {
        int q0, h;
        if (u < US_) { h = u % NH; q0 = MP + (u / NH) * 32; } else { const int v = u - US_; h = v % NH; q0 = (v / NH) * 32; }
        int t, S, base; seqpos(q0, t, S, base);
        bf16x8 qf[6];
#pragma unroll
        for (int s = 0; s < 6; ++s) qf[s] = *(const bf16x8*)(F.Q + (size_t)(q0 + r32) * NQ + h * QKD + 16 * s + 8 * hi);
        f32x16 o0 = {}, o1 = {};
        float mrun = -1e30f, lrun = 0.f;
        for (int kv0 = 0; kv0 < S; kv0 += 32) {
            f32x16 x = {};
            const bf16* kp = F.K + (size_t)(base + kv0 + r32) * NQ + h * QKD + 8 * hi;
#pragma unroll
            for (int s = 0; s < 6; ++s) { const bf16x8 kf = *(const bf16x8*)(kp + 16 * s); x = __builtin_amdgcn_mfma_f32_32x32x16_bf16(kf, qf[s], x, 0, 0, 0); }
            float mx = x[0];
#pragma unroll
            for (int r = 1; r < 16; ++r) mx = fmaxf(mx, x[r]);
            mx = fmaxf(mx, __shfl_xor(mx, 32));
            const float mnew = fmaxf(mrun, mx), alpha = __builtin_amdgcn_exp2f(mrun - mnew);
            float ls = 0.f;
#pragma unroll
            for (int r = 0; r < 16; ++r) { x[r] = __builtin_amdgcn_exp2f(x[r] - mnew); ls += x[r]; }
            ls += __shfl_xor(ls, 32);
            lrun = lrun * alpha + ls; mrun = mnew;
#pragma unroll
            for (int r = 0; r < 16; ++r) { const float a = __shfl(alpha, crow(r, hi)); o0[r] *= a; o1[r] *= a; }
#pragma unroll
            for (int s = 0; s < 2; ++s) {
                bf16x8 pa;
#pragma unroll
                for (int j = 0; j < 8; ++j) pa[j] = (short)f2bf(x[8 * s + j]);
                bf16x8 v0, v1;
#pragma unroll
                for (int j = 0; j < 8; ++j) { const bf16* vp = F.V + (size_t)(base + kv0 + crow(8 * s + j, hi)) * 512 + h * VD + r32; v0[j] = (short)vp[0]; v1[j] = (short)vp[32]; }
                o0 = __builtin_amdgcn_mfma_f32_32x32x16_bf16(pa, v0, o0, 0, 0, 0);
                o1 = __builtin_amdgcn_mfma_f32_32x32x16_bf16(pa, v1, o1, 0, 0, 0);
            }
        }
        const float linv = 1.0f / lrun;
#pragma unroll
        for (int r = 0; r < 16; ++r) { const float li = __shfl(linv, crow(r, hi)); const size_t row = q0 + crow(r, hi);
            F.MIX[row * DM + 512 + h * VD + r32] = (bf16)f2bf(o0[r] * li); F.MIX[row * DM + 512 + h * VD + 32 + r32] = (bf16)f2bf(o1[r] * li); }
    }
}

__device__ __forceinline__ void up_simple(const Frame& F) {
    const int lane = F.lane, fr = lane & 15, fq = lane >> 4;
    LAS float* U = (LAS float*)(F.lds + F.wave * 16640);
    constexpr int RT_P = (SP + 61) / 62, RT_S = (SS + 61) / 62, NRT = 16 * RT_P + 2 * RT_S, NFT = DFF / 32;
    for (int tile = F.gw; tile < NRT * NFT; tile += F.ngw) {
        const int rt = tile / NFT, f0 = (tile % NFT) * 32;
        int base, S, R0;
        if (rt < 16 * RT_P) { base = (rt / RT_P) * SP; S = SP; R0 = (rt % RT_P) * 62; } else { const int q = rt - 16 * RT_P; base = MP + (q / RT_S) * SS; S = SS; R0 = (q % RT_S) * 62; }
        f32x4 acc[4][4];
#pragma unroll
        for (int i = 0; i < 4; ++i)
#pragma unroll
            for (int j = 0; j < 4; ++j) acc[i][j] = (f32x4){0.f, 0.f, 0.f, 0.f};
        const bf16* ap[4];
#pragma unroll
        for (int i = 0; i < 4; ++i) { int p = R0 - 1 + 16 * i + fr; p = p < 0 ? 0 : (p >= S ? S - 1 : p); ap[i] = F.H2 + (size_t)(base + p) * DM + fq * 8; }
        const bf16* bp[4];
#pragma unroll
        for (int j = 0; j < 4; ++j) { const int f = f0 + 16 * (j & 1) + fr; const int drow = 256 * (f / 128) + (j >> 1) * 128 + (f % 128); bp[j] = F.Wup_t + (size_t)drow * DM + fq * 8; }
        for (int k0 = 0; k0 < DM; k0 += 32) {
            bf16x8 a[4], b[4];
#pragma unroll
            for (int i = 0; i < 4; ++i) a[i] = *(const bf16x8*)(ap[i] + k0);
#pragma unroll
            for (int j = 0; j < 4; ++j) b[j] = *(const bf16x8*)(bp[j] + k0);
#pragma unroll
            for (int i = 0; i < 4; ++i)
#pragma unroll
                for (int j = 0; j < 4; ++j) acc[i][j] = __builtin_amdgcn_mfma_f32_16x16x32_bf16(a[i], b[j], acc[i][j], 0, 0, 0);
        }
#pragma unroll
        for (int i = 0; i < 4; ++i)
#pragma unroll
            for (int r = 0; r < 4; ++r) { const int lr = 16 * i + 4 * fq + r, p = R0 - 1 + lr; const bool ok = (p >= 0) && (p < S);
#pragma unroll
                for (int j = 0; j < 4; ++j) U[lr * 65 + 16 * j + fr] = ok ? acc[i][j][r] : 0.f; }
        LDS_WAIT(); asm volatile("" ::: "memory");
        const int c = lane & 31, f = f0 + c;
        const float bg = F.conv_b[f], bv = F.conv_b[DFF + f];
        const float g0 = F.conv_w[f], g1 = F.conv_w[NUP + f], g2 = F.conv_w[2 * NUP + f];
        const float w0 = F.conv_w[DFF + f], w1 = F.conv_w[NUP + DFF + f], w2 = F.conv_w[2 * NUP + DFF + f];
        for (int k = 0; k < 31; ++k) { const int lr = 1 + (lane >> 5) + 2 * k, p = R0 - 1 + lr;
            if (p < S) {
                const float cg = bg + g0 * U[(lr - 1) * 65 + c] + g1 * U[lr * 65 + c] + g2 * U[(lr + 1) * 65 + c];
                const float cv = bv + w0 * U[(lr - 1) * 65 + 32 + c] + w1 * U[lr * 65 + 32 + c] + w2 * U[(lr + 1) * 65 + 32 + c];
                const float act = cg / (1.0f + __expf(-cg)) * cv;
                F.ACT[(size_t)(base + p) * DFF + f] = (bf16)f2bf(act); } }
        LDS_WAIT(); asm volatile("" ::: "memory");
    }
}

constexpr int N_PHASES = 10;
__global__ void __launch_bounds__(NWAVES * 64, 2) mega_fwd(Args args) {
    extern __shared__ __attribute__((aligned(16))) unsigned char lds[];
    Frame F;
    F.lds = (LAS unsigned char*)lds;
    F.tid = threadIdx.x; F.lane = F.tid & 63; F.wave = __builtin_amdgcn_readfirstlane(F.tid >> 6);
    F.G = gridDim.x; F.gw = blockIdx.x * NWAVES + F.wave; F.ngw = F.G * NWAVES;
    F.xp = args.in[0]; F.xs = args.in[1]; F.g_mix = args.in[2]; F.w_in = args.in[3]; F.g_q = args.in[4]; F.w_uq = args.in[5]; F.g_kv = args.in[6]; F.w_ukv = args.in[7];
    F.w_pool = args.in[8]; F.pool_scale = args.in[9]; F.w_out = args.in[10]; F.g_ffn = args.in[11]; F.w_up = args.in[12]; F.conv_w = args.in[13]; F.conv_b = args.in[14];
    F.w_down = args.in[15]; F.g_final = args.in[16]; F.out = args.out;
    unsigned char* ws = args.ws;
    F.Win_t = (bf16*)(ws + WS_WIN); F.Wout_t = (bf16*)(ws + WS_WOUT); F.Wuq_t = (bf16*)(ws + WS_WUQ); F.Wukv_t = (bf16*)(ws + WS_WUKV); F.Wpool_t = (bf16*)(ws + WS_WPOOL);
    F.Wup_t = (bf16*)(ws + WS_WUP); F.Wdown_t = (bf16*)(ws + WS_WDOWN); F.COS = (float*)(ws + WS_COS); F.SIN = (float*)(ws + WS_SIN);
    F.HB = (bf16*)(ws + WS_HB); F.MIX = (bf16*)(ws + WS_MIX); F.Z = (bf16*)(ws + WS_Z); F.H2 = (bf16*)(ws + WS_H2); F.POOLED = (bf16*)(ws + WS_POOLED);
    F.QN = (bf16*)(ws + WS_QN); F.KVN = (bf16*)(ws + WS_KVN); F.Q = (bf16*)(ws + WS_Q); F.K = (bf16*)(ws + WS_K); F.V = (bf16*)(ws + WS_V); F.ACT = (bf16*)(ws + WS_ACT);
    volatile LAS unsigned* MISC = (volatile LAS unsigned*)(F.lds + MISC_OFF);
    for (int u = F.tid; u < (LDS_BYTES - MISC_OFF) / 4; u += NWAVES * 64) ((LAS unsigned*)(F.lds + MISC_OFF))[u] = 0u;
    __syncthreads();
    const int lo = args.ph_lo, hi = args.ph_hi;
    XcdBarrier bar; bar.bar = (unsigned*)(ws + WS_CTL) + CW_BAR; bar.x = 0; bar.st = nullptr;
    if (hi - lo > 1) bar = xcd_barrier_post((unsigned*)(ws + WS_CTL) + CW_BAR, MISC + 8);
#define IN(k) (lo <= (k) && (k) < hi)
#define SEAM(k) do { if (IN(k) && IN((k) + 1)) xcd_barrier(bar); } while (0)

    if (IN(0)) { p0_prologue(F, args); } SEAM(0);
    if (IN(1)) { EpiZ E{F.Z}; sgemm(F, F.HB, DM, 0, F.Win_t, DM, M, NZ, E); } SEAM(1);
    if (IN(2)) { p2_rows(F); } SEAM(2);
    if (IN(3)) {
        { EpiQ E{F.Q, F.COS, F.SIN}; sgemm(F, F.QN, 256, 0, F.Wuq_t, 256, M, NQ, E); }
        { EpiKV E{F.K, F.V}; sgemm(F, F.KVN, 128, 0, F.Wukv_t, 128, M, NKV, E); }
        { EpiPool E{F.MIX, F.pool_scale}; sgemm(F, F.POOLED, 512, 256, F.Wpool_t, 256, M, 512, E); }
    } SEAM(3);
    if (IN(4)) { attn_simple(F); } SEAM(4);
    if (IN(5)) { EpiWo E{F.xp, F.xs, F.out}; sgemm(F, F.MIX, DM, 0, F.Wout_t, DM, M, DM, E); } SEAM(5);
    if (IN(6)) { for (int m = F.gw; m < M; m += F.ngw) rms_row_to_bf16(F, F.out + (size_t)m * DM, F.g_ffn, F.H2 + (size_t)m * DM); } SEAM(6);
    if (IN(7)) { up_simple(F); } SEAM(7);
    if (IN(8)) { EpiDown E{F.out}; sgemm(F, F.ACT, DFF, 0, F.Wdown_t, DFF, M, DM, E); } SEAM(8);
    if (IN(9)) {
        for (int m = F.gw; m < M; m += F.ngw) {
            GAS f32x4* xr = (GAS f32x4*)(F.out + (size_t)m * DM) + F.lane; const GAS f32x4* gr = (const GAS f32x4*)F.g_final + F.lane;
            f32x4 v[4]; float s = 0.f;
#pragma unroll
            for (int j = 0; j < 4; ++j) { v[j] = xr[64 * j]; s += (v[j].x * v[j].x + v[j].y * v[j].y) + (v[j].z * v[j].z + v[j].w * v[j].w); }
            const float rstd = 1.0f / sqrtf(wave_sum(s) * (1.f / DM) + EPS);
#pragma unroll
            for (int j = 0; j < 4; ++j) xr[64 * j] = v[j] * rstd * gr[64 * j];
        }
    }
#undef IN
#undef SEAM
}

extern "C" void kernel_launch(void* const* d_in, const int* in_sizes, int n_in, void* d_out, int out_size, void* d_ws, size_t ws_size, hipStream_t stream) {
    static int grid = 0;
    if (grid == 0) {
        if (n_in != 17 || out_size != M * DM || ws_size < WS_END) { fprintf(stderr, "kernel_launch: unexpected shapes (n_in %d, out %d, ws %zu)\n", n_in, out_size, ws_size); grid = -1; return; }
        int dev = 0, cus = 0, per_cu = 0;
        if (hipGetDevice(&dev) != hipSuccess || hipDeviceGetAttribute(&cus, hipDeviceAttributeMultiprocessorCount, dev) != hipSuccess) { grid = -1; return; }
        if (hipFuncSetAttribute((const void*)mega_fwd, hipFuncAttributeMaxDynamicSharedMemorySize, LDS_BYTES) != hipSuccess) { fprintf(stderr, "kernel_launch: hipFuncSetAttribute failed\n"); grid = -1; return; }
        if (hipOccupancyMaxActiveBlocksPerMultiprocessor(&per_cu, (const void*)mega_fwd, NWAVES * 64, LDS_BYTES) != hipSuccess || per_cu < 1) { fprintf(stderr, "kernel_launch: occupancy query says %d\n", per_cu); per_cu = 1; }
        (void)hipGetLastError();
        grid = cus;
    }
    if (grid < 0) return;
    (void)hipMemsetAsync((char*)d_ws + WS_CTL, 0, CTL_ZERO_BYTES, stream);
    Args a{};
    for (int i = 0; i < 17; ++i) a.in[i] = (const float*)d_in[i];
    a.out = (float*)d_out; a.ws = (unsigned char*)d_ws;
    for (int i = 0; i < 16; ++i) a.freq_rev[i] = std::pow(10000.0, -(double)i / 16.0) / 6.283185307179586476925287;
#if MK_N_LAUNCHES == 1
    a.ph_lo = 0; a.ph_hi = N_PHASES;
    hipLaunchKernelGGL(mega_fwd, dim3(grid), dim3(NWAVES * 64), LDS_BYTES, stream, a);
#else
    for (int p = 0; p < N_PHASES; ++p) { a.ph_lo = p; a.ph_hi = p + 1; hipLaunchKernelGGL(mega_fwd, dim3(grid), dim3(NWAVES * 64), LDS_BYTES, stream, a); }
#endif
}
```

```cpp
#include <hip/hip_runtime.h>
#include <cstdio>
#include <cstdint>
#include <cmath>

#ifndef MK_N_LAUNCHES
#define MK_N_LAUNCHES 1
#endif

#ifndef FAST_G1
#define FAST_G1 1
#endif
#ifndef FAST_G2
#define FAST_G2 1
#endif
#ifndef FAST_WO
#define FAST_WO 1
#endif
#ifndef DEFER_NORM
#define DEFER_NORM 1
#endif
#ifndef FAST_DOWN
#define FAST_DOWN 1
#endif
#ifndef FAST_UP
#define FAST_UP 1
#endif

#define GAS __attribute__((address_space(1)))
#define LAS __attribute__((address_space(3)))
typedef unsigned short bf16;
typedef short bf16x8 __attribute__((ext_vector_type(8)));
typedef float f32x4 __attribute__((ext_vector_type(4)));
typedef float f32x16 __attribute__((ext_vector_type(16)));
typedef unsigned v4u __attribute__((ext_vector_type(4)));
typedef unsigned v2u __attribute__((ext_vector_type(2)));
typedef GAS unsigned gu32;

constexpr int DM = 1024, MP = 16 * 2048, MS = 2 * 8192, M = MP + MS;
constexpr int SP = 2048, SS = 8192;
constexpr int NZ = 1024;
constexpr int NH = 8, QKD = 96, VD = 64, NQ = NH * QKD  , NKV = NH * 128  ;
constexpr int DFF = 2816, NUP = 2 * DFF;
constexpr float EPS = 1e-6f;
constexpr float C2 = 0.10206207261596577f * 1.4426950408889634f;

constexpr size_t MiB = 1u << 20;
constexpr size_t WS_CTL = 0, CTL_ZERO_BYTES = 1 * MiB;
constexpr size_t WS_WIN = 1 * MiB, WS_WOUT = 3 * MiB, WS_WUQ = 5 * MiB, WS_WUKV = 5 * MiB + 512 * 1024, WS_WPOOL = 6 * MiB, WS_WUP = 7 * MiB, WS_WDOWN = 18 * MiB;
constexpr size_t WS_COS = 23 * MiB + 512 * 1024, WS_SIN = WS_COS + 512 * 1024 / 2 * 2;
constexpr size_t WS_RS = 24 * MiB + 512 * 1024;
constexpr size_t WS_HB = 26 * MiB;
constexpr size_t WS_MIX = WS_HB;
constexpr size_t WS_Z = WS_HB + 96 * MiB;
constexpr size_t WS_H2 = WS_Z;
constexpr size_t WS_POOLED = WS_Z + 96 * MiB;
constexpr size_t WS_QN = WS_POOLED + 48 * MiB;
constexpr size_t WS_KVN = WS_QN + 24 * MiB;
constexpr size_t WS_Q = WS_KVN + 12 * MiB;
constexpr size_t WS_K = WS_Q + 72 * MiB;
constexpr size_t WS_V = WS_K + 72 * MiB;
constexpr size_t WS_ACT = WS_POOLED;
constexpr size_t WS_END = WS_V + 48 * MiB;
static_assert(WS_SIN + 512 * 1024 <= WS_RS && WS_RS + (size_t)4 * M * 4 <= WS_HB, "tables");
static_assert(WS_ACT + (size_t)M * DFF * 2 <= WS_END, "ACT overlay");
static_assert(WS_END <= 512 * MiB, "workspace budget");

constexpr int CW_BAR = 4096;

__device__ __forceinline__ unsigned f2bf(float f) { unsigned u = __builtin_bit_cast(unsigned, f); return (u + 0x7fffu + ((u >> 16) & 1u)) >> 16; }
__device__ __forceinline__ unsigned pk2(float lo, float hi) { return f2bf(lo) | (f2bf(hi) << 16); }
__device__ __forceinline__ float bf2f(unsigned short b) { return __builtin_bit_cast(float, (unsigned)b << 16); }
__device__ __forceinline__ float wave_sum(float v) {
#pragma unroll
    for (int o = 1; o < 64; o <<= 1) v += __shfl_xor(v, o);
    return v;
}
__device__ __forceinline__ int lane_id_fresh() { int l; asm volatile("v_mbcnt_lo_u32_b32 %0, -1, 0\n\tv_mbcnt_hi_u32_b32 %0, -1, %0" : "=v"(l)); return l; }
#define LDS_WAIT() asm volatile("s_waitcnt lgkmcnt(0)" ::: "memory")
#define VM_WAIT() asm volatile("s_waitcnt vmcnt(0)" ::: "memory")

#define XB_TMO      128
#define XB_XCNT(j)  (256  + 64 * (j))
#define XB_XSUB(j)  (1280 + 64 * (j))
#define XB_XGEN(j)  (2304 + 64 * (j))
#define XB_TOP      3328
#define XB_TOPGEN   3392
#define XCD_BAR_WORDS 3456
#define XB_SPIN_CAP (1u << 22)
__device__ __forceinline__ unsigned xb_ld(unsigned* p)              { return __hip_atomic_load(p, __ATOMIC_RELAXED, __HIP_MEMORY_SCOPE_AGENT); }
__device__ __forceinline__ unsigned xb_add(unsigned* p, unsigned v) { return __hip_atomic_fetch_add(p, v, __ATOMIC_RELAXED, __HIP_MEMORY_SCOPE_AGENT); }
__device__ __forceinline__ unsigned xb_xcc_id() { return (unsigned)__builtin_amdgcn_s_getreg((3 << 11) | 20) & 0xFu; }
#define XB_SPIN(cond, bar) do { unsigned _sp = 0; while (cond) { __builtin_amdgcn_s_sleep(1); \
    if ((++_sp & 255u) == 0u) { if (xb_ld(&(bar)[XB_TMO])) break; if (_sp > XB_SPIN_CAP) { atomicAdd(&(bar)[XB_TMO], 1u); break; } } } } while (0)
struct XcdBarrier { unsigned* bar; unsigned x; volatile LAS unsigned* st; };
__device__ __forceinline__ XcdBarrier xcd_barrier_post(unsigned* bar, volatile LAS unsigned* st, int wave) {
    XcdBarrier b; b.bar = bar; b.x = xb_xcc_id(); b.st = st;
    if (wave == 0 && lane_id_fresh() == 0) (void)xb_add(&bar[XB_XCNT(b.x)], 1u);
    return b;
}
__device__ __forceinline__ void xcd_barrier_complete(unsigned* bar, unsigned x, unsigned& nloc, unsigned& nx) {
    const unsigned G = gridDim.x * gridDim.y * gridDim.z;
    unsigned sum, cnt, mine, sp = 0u;
    for (;;) {
        sum = 0u; cnt = 0u; mine = 0u;
#pragma unroll
        for (unsigned j = 0; j < 16; ++j) { const unsigned c = xb_ld(&bar[XB_XCNT(j)]); sum += c; cnt += (c > 0u) ? 1u : 0u; mine = (j == x) ? c : mine; }
        if (sum == G) break;
        __builtin_amdgcn_s_sleep(1);
        if ((++sp & 255u) == 0u) { if (xb_ld(&bar[XB_TMO])) break; if (sp > XB_SPIN_CAP) { atomicAdd(&bar[XB_TMO], 1u); break; } }
    }
    nloc = mine > 0u ? mine : 1u; nx = cnt > 0u ? cnt : 1u;
}
__device__ __forceinline__ void xcd_barrier(const XcdBarrier& b, int wave) {
    asm volatile("s_waitcnt vmcnt(0)" ::: "memory");
    __syncthreads();
    if (wave == 0 && lane_id_fresh() == 0) {
        unsigned* bar = b.bar;
        __builtin_amdgcn_s_waitcnt(0);
        unsigned nloc = b.st[0], nx = b.st[1];
        if (nloc == 0u) { xcd_barrier_complete(bar, b.x, nloc, nx); b.st[0] = nloc; b.st[1] = nx; }
        const unsigned old = xb_add(&bar[XB_XSUB(b.x)], 1u);
        const unsigned gen = old / nloc;
        if (old + 1u == (gen + 1u) * nloc) {
            __builtin_amdgcn_fence(__ATOMIC_RELEASE, "agent");
            asm volatile("s_waitcnt vmcnt(0)" ::: "memory");
            const unsigned og = xb_add(&bar[XB_TOP], 1u);
            const unsigned tg = og / nx;
            if (og + 1u == (tg + 1u) * nx) xb_add(&bar[XB_TOPGEN], 1u);
            else XB_SPIN(xb_ld(&bar[XB_TOPGEN]) == tg, bar);
            __builtin_amdgcn_fence(__ATOMIC_ACQUIRE, "agent");
            xb_add(&bar[XB_XGEN(b.x)], 1u);
            asm volatile("s_waitcnt vmcnt(0)" ::: "memory");
        } else {
            XB_SPIN(xb_ld(&bar[XB_XGEN(b.x)]) == gen, bar);
            __builtin_amdgcn_fence(__ATOMIC_ACQUIRE, "agent");
            asm volatile("s_waitcnt vmcnt(0)" ::: "memory");
        }
    }
    __syncthreads();
}

constexpr int NWAVES = 8;
constexpr int RING_BYTES = 139264;
constexpr int MISC_OFF = RING_BYTES;
constexpr int LDS_BYTES = 147456;

struct Args {
    const float* in[17]; float* out; unsigned char* ws;
    double freq_rev[16];
    int ph_lo, ph_hi;
};
struct Frame {
    const __attribute__((address_space(4))) Args* a;
    LAS unsigned char* lds;
    int tid, lane, wave, gw, ngw, G;
    const float *xp, *xs, *g_mix, *w_in, *g_q, *w_uq, *g_kv, *w_ukv, *w_pool, *pool_scale, *w_out, *g_ffn, *w_up, *conv_w, *conv_b, *w_down, *g_final;
    float* out;
    bf16 *Win_t, *Wout_t, *Wuq_t, *Wukv_t, *Wpool_t, *Wup_t, *Wdown_t;
    float *COS, *SIN, *RS;
    bf16 *HB, *MIX, *Z, *H2, *POOLED, *QN, *KVN, *Q, *K, *V, *ACT;
};
typedef const __attribute__((address_space(4))) Args* CArgs;
__device__ __forceinline__ Frame make_frame(LAS unsigned char* lds, int wave) {
    CArgs a = (CArgs)__builtin_amdgcn_kernarg_segment_ptr(); asm volatile("" : "+s"(a));
    Frame F; F.a = a;
    F.lds = lds;
    F.wave = wave; F.lane = lane_id_fresh(); F.tid = wave * 64 + F.lane;
    F.G = gridDim.x; F.gw = blockIdx.x * NWAVES + F.wave; F.ngw = F.G * NWAVES;
    F.xp = a->in[0]; F.xs = a->in[1]; F.g_mix = a->in[2]; F.w_in = a->in[3]; F.g_q = a->in[4]; F.w_uq = a->in[5]; F.g_kv = a->in[6]; F.w_ukv = a->in[7];
    F.w_pool = a->in[8]; F.pool_scale = a->in[9]; F.w_out = a->in[10]; F.g_ffn = a->in[11]; F.w_up = a->in[12]; F.conv_w = a->in[13]; F.conv_b = a->in[14];
    F.w_down = a->in[15]; F.g_final = a->in[16]; F.out = a->out;
    unsigned char* ws = a->ws;
    F.Win_t = (bf16*)(ws + WS_WIN); F.Wout_t = (bf16*)(ws + WS_WOUT); F.Wuq_t = (bf16*)(ws + WS_WUQ); F.Wukv_t = (bf16*)(ws + WS_WUKV); F.Wpool_t = (bf16*)(ws + WS_WPOOL);
    F.Wup_t = (bf16*)(ws + WS_WUP); F.Wdown_t = (bf16*)(ws + WS_WDOWN); F.COS = (float*)(ws + WS_COS); F.SIN = (float*)(ws + WS_SIN); F.RS = (float*)(ws + WS_RS);
    F.HB = (bf16*)(ws + WS_HB); F.MIX = (bf16*)(ws + WS_MIX); F.Z = (bf16*)(ws + WS_Z); F.H2 = (bf16*)(ws + WS_H2); F.POOLED = (bf16*)(ws + WS_POOLED);
    F.QN = (bf16*)(ws + WS_QN); F.KVN = (bf16*)(ws + WS_KVN); F.Q = (bf16*)(ws + WS_Q); F.K = (bf16*)(ws + WS_K); F.V = (bf16*)(ws + WS_V); F.ACT = (bf16*)(ws + WS_ACT);
    return F;
}
__device__ __forceinline__ const float* xrow(const Frame& F, int m) { return m < MP ? F.xp + (size_t)m * DM : F.xs + (size_t)(m - MP) * DM; }
__device__ __forceinline__ void seqpos(int m, int& t, int& S, int& base) {
    if (m < MP) { S = SP; t = m & (SP - 1); base = m - t; } else { S = SS; t = (m - MP) & (SS - 1); base = m - t; }
}

__device__ __forceinline__ void transpose_item(const float* W, int K, int N, bf16* WT, int k0, int n0, int drow0, LAS float* scr, int lane) {
#pragma unroll 8
    for (int i = 0; i < 32; ++i) { const int kk = 2 * i + (lane >> 5); scr[kk * 33 + (lane & 31)] = W[(size_t)(k0 + kk) * N + n0 + (lane & 31)]; }
    LDS_WAIT(); asm volatile("" ::: "memory");
    const int c = lane & 7;
#pragma unroll
    for (int j = 0; j < 4; ++j) { const int n = (lane >> 3) + 8 * j; const LAS float* s = scr + (8 * c) * 33 + n;
        v4u o; o.x = pk2(s[0 * 33], s[1 * 33]); o.y = pk2(s[2 * 33], s[3 * 33]); o.z = pk2(s[4 * 33], s[5 * 33]); o.w = pk2(s[6 * 33], s[7 * 33]);
        *(GAS v4u*)(WT + (size_t)(drow0 + n) * K + k0 + 8 * c) = o; }
    LDS_WAIT(); asm volatile("" ::: "memory");
}
__device__ __forceinline__ void rms_row_to_bf16(const Frame& F, const float* xr_, const float* g, bf16* orow) {
    const GAS f32x4* xr = (const GAS f32x4*)xr_ + F.lane; const GAS f32x4* gr = (const GAS f32x4*)g + F.lane;
    f32x4 v[4]; float s = 0.f;
#pragma unroll
    for (int j = 0; j < 4; ++j) { v[j] = xr[64 * j]; s += (v[j].x * v[j].x + v[j].y * v[j].y) + (v[j].z * v[j].z + v[j].w * v[j].w); }
    const float rstd = 1.0f / sqrtf(wave_sum(s) * (1.f / DM) + EPS);
    GAS unsigned long long* o8 = (GAS unsigned long long*)orow + F.lane;
#pragma unroll
    for (int j = 0; j < 4; ++j) { const f32x4 gg = gr[64 * j];
        o8[64 * j] = (unsigned long long)pk2(v[j].x * rstd * gg.x, v[j].y * rstd * gg.y) | ((unsigned long long)pk2(v[j].z * rstd * gg.z, v[j].w * rstd * gg.w) << 32); }
}
__device__ __forceinline__ void p0_prologue(const Frame& F) {
    LAS float* scr = (LAS float*)(F.lds + F.wave * 16384);
    constexpr int I_IN = (1024 / 64) * (928 / 32), I_OUT = (1024 / 64) * (1024 / 32), I_UQ = (256 / 64) * (768 / 32), I_UKV = (128 / 64) * (1024 / 32),
                  I_UP = (1024 / 64) * (NUP / 32), I_DOWN = (DFF / 64) * (1024 / 32);
    constexpr int NITEMS = I_IN + I_OUT + I_UQ + I_UKV + I_UP + I_DOWN;
    for (int it = F.gw; it < NITEMS; it += F.ngw) {
        int r = it;
        if (r < I_IN) { const int nb = 928 / 32, kb = r / nb, n0 = (r % nb) * 32; transpose_item(F.w_in, 1024, 928, F.Win_t, kb * 64, n0, n0, scr, F.lane); continue; } r -= I_IN;
        if (r < I_OUT) { const int nb = 32, kb = r / nb, n0 = (r % nb) * 32; transpose_item(F.w_out, 1024, 1024, F.Wout_t, kb * 64, n0, n0, scr, F.lane); continue; } r -= I_OUT;
        if (r < I_UQ) { const int nb = 768 / 32, kb = r / nb, n0 = (r % nb) * 32; transpose_item(F.w_uq, 256, 768, F.Wuq_t, kb * 64, n0, n0, scr, F.lane); continue; } r -= I_UQ;
        if (r < I_UKV) { const int nb = 32, kb = r / nb, n0 = (r % nb) * 32; transpose_item(F.w_ukv, 128, 1024, F.Wukv_t, kb * 64, n0, n0, scr, F.lane); continue; } r -= I_UKV;
        if (r < I_UP) { const int nb = NUP / 32, kb = r / nb, n0 = (r % nb) * 32;
            const int f = n0 < DFF ? n0 : n0 - DFF; const int drow = 256 * (f / 128) + (n0 < DFF ? 0 : 128) + (f % 128);
            transpose_item(F.w_up, 1024, NUP, F.Wup_t, kb * 64, n0, drow, scr, F.lane); continue; } r -= I_UP;
        { const int nb = 32, kb = r / nb, n0 = (r % nb) * 32; transpose_item(F.w_down, DFF, 1024, F.Wdown_t, kb * 64, n0, n0, scr, F.lane); }
    }
    const int gt = F.gw * 64 + F.lane, ngt = F.ngw * 64;
    for (int i = gt; i < 96 * 1024 / 2; i += ngt) ((GAS unsigned*)(F.Win_t + 928 * 1024))[i] = 0u;
    for (int i = gt; i < 512 * 256; i += ngt) { const int n = i >> 8, k = i & 255; const int g = n >> 7, d = n & 127, pc = 256 * (n >> 8) + k, gp = pc >> 7;
        const float w = (gp == g) ? F.w_pool[((size_t)g * 128 + (pc & 127)) * 128 + d] : 0.f; F.Wpool_t[i] = (bf16)f2bf(w); }
    for (int i = gt; i < SS * 16; i += ngt) { const int t = i >> 4, j = i & 15; const double rev = (double)t * F.a->freq_rev[j]; const float fr = (float)(rev - floor(rev));
        F.COS[i] = __builtin_amdgcn_cosf(fr); F.SIN[i] = __builtin_amdgcn_sinf(fr); }
    for (int m = F.gw; m < M; m += F.ngw) rms_row_to_bf16(F, xrow(F, m), F.g_mix, F.HB + (size_t)m * DM);
}

template <class Epi>
__device__ __forceinline__ void sgemm(const Frame& F, const bf16* A, int lda, int a_noff, const bf16* Bt, int K, int Mr, int N, const Epi& E) {
    const int fr = F.lane & 15, fq = F.lane >> 4;
    const int tn = N / 64, tiles = (Mr / 64) * tn;
    for (int tile = F.gw; tile < tiles; tile += F.ngw) {
        const int r0 = (tile / tn) * 64, c0 = (tile % tn) * 64;
        f32x4 acc[4][4];
#pragma unroll
        for (int i = 0; i < 4; ++i)
#pragma unroll
            for (int j = 0; j < 4; ++j) acc[i][j] = (f32x4){0.f, 0.f, 0.f, 0.f};
        const bf16* Ab = A + (size_t)(r0 + fr) * lda + (c0 / 256) * a_noff + fq * 8;
        const bf16* Bb = Bt + (size_t)(c0 + fr) * K + fq * 8;
        for (int k0 = 0; k0 < K; k0 += 32) {
            bf16x8 a[4], b[4];
#pragma unroll
            for (int i = 0; i < 4; ++i) a[i] = *(const bf16x8*)(Ab + (size_t)i * 16 * lda + k0);
#pragma unroll
            for (int j = 0; j < 4; ++j) b[j] = *(const bf16x8*)(Bb + (size_t)j * 16 * K + k0);
#pragma unroll
            for (int i = 0; i < 4; ++i)
#pragma unroll
                for (int j = 0; j < 4; ++j) acc[i][j] = __builtin_amdgcn_mfma_f32_16x16x32_bf16(a[i], b[j], acc[i][j], 0, 0, 0);
        }
        E(acc, r0, c0, fr, fq);
    }
}
struct EpiZ { bf16* Z;
    __device__ __forceinline__ void operator()(const f32x4 (&acc)[4][4], int r0, int c0, int fr, int fq) const {
#pragma unroll
        for (int i = 0; i < 4; ++i)
#pragma unroll
            for (int r = 0; r < 4; ++r) { const size_t row = r0 + 16 * i + 4 * fq + r;
#pragma unroll
                for (int j = 0; j < 4; ++j) Z[row * NZ + c0 + 16 * j + fr] = (bf16)f2bf(acc[i][j][r]); } } };
struct EpiQ { bf16* Q; const float* COS; const float* SIN;
    __device__ __forceinline__ void operator()(const f32x4 (&acc)[4][4], int r0, int c0, int fr, int fq) const {
#pragma unroll
        for (int i = 0; i < 4; ++i)
#pragma unroll
            for (int r = 0; r < 4; ++r) { const int row = r0 + 16 * i + 4 * fq + r; int t, S, base; seqpos(row, t, S, base);
                const float cs = COS[t * 16 + fr], sn = SIN[t * 16 + fr];
#pragma unroll
                for (int j = 0; j < 4; ++j) { const int blk = ((c0 >> 4) + j) % 6; const size_t o = (size_t)row * NQ + c0 + 16 * j + fr;
                    if (blk < 4) Q[o] = (bf16)f2bf(acc[i][j][r] * C2);
                    else if (blk == 4) { if (j < 3) { const float x1 = acc[i][j][r], x2 = acc[i][j < 3 ? j + 1 : j][r];
                        Q[o] = (bf16)f2bf((x1 * cs - x2 * sn) * C2); Q[o + 16] = (bf16)f2bf((x2 * cs + x1 * sn) * C2); } } } } } };
struct EpiKV { bf16* K; bf16* V;
    __device__ __forceinline__ void operator()(const f32x4 (&acc)[4][4], int r0, int c0, int fr, int fq) const {
#pragma unroll
        for (int i = 0; i < 4; ++i)
#pragma unroll
            for (int r = 0; r < 4; ++r) { const size_t row = r0 + 16 * i + 4 * fq + r;
#pragma unroll
                for (int j = 0; j < 4; ++j) { const int col = c0 + 16 * j + fr, h = col >> 7, d = col & 127;
                    if (d < 64) K[row * NQ + h * QKD + d] = (bf16)f2bf(acc[i][j][r]); else V[row * 512 + h * VD + (d - 64)] = (bf16)f2bf(acc[i][j][r]); } } } };
struct EpiPool { bf16* MIX; const float* scale;
    __device__ __forceinline__ void operator()(const f32x4 (&acc)[4][4], int r0, int c0, int fr, int fq) const {
#pragma unroll
        for (int j = 0; j < 4; ++j) { const int col = c0 + 16 * j + fr; const float sc = scale[col];
#pragma unroll
            for (int i = 0; i < 4; ++i)
#pragma unroll
                for (int r = 0; r < 4; ++r) { const size_t row = r0 + 16 * i + 4 * fq + r; MIX[row * DM + col] = (bf16)f2bf(acc[i][j][r] * sc); } } } };
struct EpiWo { const float* xp; const float* xs; float* out;
    __device__ __forceinline__ void operator()(const f32x4 (&acc)[4][4], int r0, int c0, int fr, int fq) const {
        const float* xb = r0 < MP ? xp + (size_t)r0 * DM : xs + (size_t)(r0 - MP) * DM;
#pragma unroll
        for (int i = 0; i < 4; ++i)
#pragma unroll
            for (int r = 0; r < 4; ++r) { const size_t lr = 16 * i + 4 * fq + r;
#pragma unroll
                for (int j = 0; j < 4; ++j) { const int col = c0 + 16 * j + fr; out[(size_t)(r0 + lr) * DM + col] = xb[lr * DM + col] + acc[i][j][r]; } } } };
struct EpiDown { float* out;
    __device__ __forceinline__ void operator()(const f32x4 (&acc)[4][4], int r0, int c0, int fr, int fq) const {
#pragma unroll
        for (int i = 0; i < 4; ++i)
#pragma unroll
            for (int r = 0; r < 4; ++r) { const size_t row = r0 + 16 * i + 4 * fq + r;
#pragma unroll
                for (int j = 0; j < 4; ++j) { const int col = c0 + 16 * j + fr; out[row * DM + col] += acc[i][j][r]; } } } };

__device__ __forceinline__ void p2_rows(const Frame& F) {
    const int lane = F.lane;
    for (int m = F.gw; m < M; m += F.ngw) {
        int t, S, base; seqpos(m, t, S, base);
        const bf16* zr = F.Z + (size_t)m * NZ;
        { const v2u w = *(const GAS v2u*)(zr + 512 + 4 * lane); float v0 = bf2f(w.x & 0xffff), v1 = bf2f(w.x >> 16), v2 = bf2f(w.y & 0xffff), v3 = bf2f(w.y >> 16);
          const float rstd = 1.0f / sqrtf(wave_sum((v0 * v0 + v1 * v1) + (v2 * v2 + v3 * v3)) * (1.f / 256.f) + EPS);
          const f32x4 g = *(const GAS f32x4*)(F.g_q + 4 * lane);
          v2u o; o.x = pk2(v0 * rstd * g.x, v1 * rstd * g.y); o.y = pk2(v2 * rstd * g.z, v3 * rstd * g.w); *(GAS v2u*)(F.QN + (size_t)m * 256 + 4 * lane) = o; }
        { const unsigned w = *(const GAS unsigned*)(zr + 768 + 2 * lane); float v0 = bf2f(w & 0xffff), v1 = bf2f(w >> 16);
          const float rstd = 1.0f / sqrtf(wave_sum(v0 * v0 + v1 * v1) * (1.f / 128.f) + EPS);
          *(GAS unsigned*)(F.KVN + (size_t)m * 128 + 2 * lane) = pk2(v0 * rstd * F.g_kv[2 * lane], v1 * rstd * F.g_kv[2 * lane + 1]); }
        { const int i = lane & 15; const float x1 = bf2f(zr[896 + i]), x2 = bf2f(zr[912 + i]); const float cs = F.COS[t * 16 + i], sn = F.SIN[t * 16 + i];
          const float o = (lane & 16) ? (x2 * cs + x1 * sn) : (x1 * cs - x2 * sn);
          const unsigned short ob = (unsigned short)f2bf(o); const int d = lane & 31;
#pragma unroll
          for (int hh = 0; hh < 4; ++hh) { const int h = 2 * hh + (lane >> 5); F.K[(size_t)m * NQ + h * QKD + 64 + d] = ob; } }
        { const int g = lane >> 4, w = 2 << g; const int lo = (t - w / 2) < 0 ? 0 : t - w / 2, hi = (t + w / 2) > S ? S : t + w / 2;
          float s[8];
#pragma unroll
          for (int e = 0; e < 8; ++e) s[e] = 0.f;
          for (int tt = lo; tt < hi; ++tt) { const v4u u = *(const GAS v4u*)(F.Z + (size_t)(base + tt) * NZ + 8 * lane);
              s[0] += bf2f(u.x & 0xffff); s[1] += bf2f(u.x >> 16); s[2] += bf2f(u.y & 0xffff); s[3] += bf2f(u.y >> 16);
              s[4] += bf2f(u.z & 0xffff); s[5] += bf2f(u.z >> 16); s[6] += bf2f(u.w & 0xffff); s[7] += bf2f(u.w >> 16); }
          const float inv = 1.0f / (float)(hi - lo);
          const v4u u = *(const GAS v4u*)(zr + 8 * lane);
          v4u o; o.x = pk2(s[0] * inv - bf2f(u.x & 0xffff), s[1] * inv - bf2f(u.x >> 16)); o.y = pk2(s[2] * inv - bf2f(u.y & 0xffff), s[3] * inv - bf2f(u.y >> 16));
          o.z = pk2(s[4] * inv - bf2f(u.z & 0xffff), s[5] * inv - bf2f(u.z >> 16)); o.w = pk2(s[6] * inv - bf2f(u.w & 0xffff), s[7] * inv - bf2f(u.w >> 16));
          *(GAS v4u*)(F.POOLED + (size_t)m * 512 + 8 * lane) = o; }
    }
}

__device__ __forceinline__ int crow(int r, int hi) { return (r & 3) + 8 * (r >> 2) + 4 * hi; }
__device__ __forceinline__ void attn_simple(const Frame& F) {
    const int lane = F.lane, r32 = lane & 31, hi = lane >> 5;
    constexpr int UP_ = MP / 32 * NH, US_ = MS / 32 * NH;
    for (int u = F.gw; u < UP_ + US_; u += F.ngw) {
        int q0, h;
        if (u < US_) { h = u % NH; q0 = MP + (u / NH) * 32; } else { const int v = u - US_; h = v % NH; q0 = (v / NH) * 32; }
        int t, S, base; seqpos(q0, t, S, base);
        bf16x8 qf[6];
#pragma unroll
        for (int s = 0; s < 6; ++s) qf[s] = *(const bf16x8*)(F.Q + (size_t)(q0 + r32) * NQ + h * QKD + 16 * s + 8 * hi);
        f32x16 o0 = {}, o1 = {};
        float mrun = -1e30f, lrun = 0.f;
        for (int kv0 = 0; kv0 < S; kv0 += 32) {
            f32x16 x = {};
            const bf16* kp = F.K + (size_t)(base + kv0 + r32) * NQ + h * QKD + 8 * hi;
#pragma unroll
            for (int s = 0; s < 6; ++s) { const bf16x8 kf = *(const bf16x8*)(kp + 16 * s); x = __builtin_amdgcn_mfma_f32_32x32x16_bf16(kf, qf[s], x, 0, 0, 0); }
            float mx = x[0];
#pragma unroll
            for (int r = 1; r < 16; ++r) mx = fmaxf(mx, x[r]);
            mx = fmaxf(mx, __shfl_xor(mx, 32));
            const float mnew = fmaxf(mrun, mx), alpha = __builtin_amdgcn_exp2f(mrun - mnew);
            float ls = 0.f;
#pragma unroll
            for (int r = 0; r < 16; ++r) { x[r] = __builtin_amdgcn_exp2f(x[r] - mnew); ls += x[r]; }
            ls += __shfl_xor(ls, 32);
            lrun = lrun * alpha + ls; mrun = mnew;
#pragma unroll
            for (int r = 0; r < 16; ++r) { const float a = __shfl(alpha, crow(r, hi)); o0[r] *= a; o1[r] *= a; }
#pragma unroll
            for (int s = 0; s < 2; ++s) {
                bf16x8 pa;
#pragma unroll
                for (int j = 0; j < 8; ++j) pa[j] = (short)f2bf(x[8 * s + j]);
                bf16x8 v0, v1;
#pragma unroll
                for (int j = 0; j < 8; ++j) { const bf16* vp = F.V + (size_t)(base + kv0 + crow(8 * s + j, hi)) * 512 + h * VD + r32; v0[j] = (short)vp[0]; v1[j] = (short)vp[32]; }
                o0 = __builtin_amdgcn_mfma_f32_32x32x16_bf16(pa, v0, o0, 0, 0, 0);
                o1 = __builtin_amdgcn_mfma_f32_32x32x16_bf16(pa, v1, o1, 0, 0, 0);
            }
        }
        const float linv = 1.0f / lrun;
#pragma unroll
        for (int r = 0; r < 16; ++r) { const float li = __shfl(linv, crow(r, hi)); const size_t row = q0 + crow(r, hi);
            F.MIX[row * DM + 512 + h * VD + r32] = (bf16)f2bf(o0[r] * li); F.MIX[row * DM + 512 + h * VD + 32 + r32] = (bf16)f2bf(o1[r] * li); }
    }
}

__device__ __forceinline__ void up_simple(const Frame& F) {
    const int lane = F.lane, fr = lane & 15, fq = lane >> 4;
    LAS float* U = (LAS float*)(F.lds + F.wave * 16640);
    constexpr int RT_P = (SP + 61) / 62, RT_S = (SS + 61) / 62, NRT = 16 * RT_P + 2 * RT_S, NFT = DFF / 32;
    for (int tile = F.gw; tile < NRT * NFT; tile += F.ngw) {
        const int rt = tile / NFT, f0 = (tile % NFT) * 32;
        int base, S, R0;
        if (rt < 16 * RT_P) { base = (rt / RT_P) * SP; S = SP; R0 = (rt % RT_P) * 62; } else { const int q = rt - 16 * RT_P; base = MP + (q / RT_S) * SS; S = SS; R0 = (q % RT_S) * 62; }
        f32x4 acc[4][4];
#pragma unroll
        for (int i = 0; i < 4; ++i)
#pragma unroll
            for (int j = 0; j < 4; ++j) acc[i][j] = (f32x4){0.f, 0.f, 0.f, 0.f};
        const bf16* ap[4];
#pragma unroll
        for (int i = 0; i < 4; ++i) { int p = R0 - 1 + 16 * i + fr; p = p < 0 ? 0 : (p >= S ? S - 1 : p); ap[i] = F.H2 + (size_t)(base + p) * DM + fq * 8; }
        const bf16* bp[4];
#pragma unroll
        for (int j = 0; j < 4; ++j) { const int f = f0 + 16 * (j & 1) + fr; const int drow = 256 * (f / 128) + (j >> 1) * 128 + (f % 128); bp[j] = F.Wup_t + (size_t)drow * DM + fq * 8; }
        for (int k0 = 0; k0 < DM; k0 += 32) {
            bf16x8 a[4], b[4];
#pragma unroll
            for (int i = 0; i < 4; ++i) a[i] = *(const bf16x8*)(ap[i] + k0);
#pragma unroll
            for (int j = 0; j < 4; ++j) b[j] = *(const bf16x8*)(bp[j] + k0);
#pragma unroll
            for (int i = 0; i < 4; ++i)
#pragma unroll
                for (int j = 0; j < 4; ++j) acc[i][j] = __builtin_amdgcn_mfma_f32_16x16x32_bf16(a[i], b[j], acc[i][j], 0, 0, 0);
        }
#pragma unroll
        for (int i = 0; i < 4; ++i)
#pragma unroll
            for (int r = 0; r < 4; ++r) { const int lr = 16 * i + 4 * fq + r, p = R0 - 1 + lr; const bool ok = (p >= 0) && (p < S);
                float rs = 1.f;
#if DEFER_NORM
                { const int pc = p < 0 ? 0 : (p >= S ? S - 1 : p); const size_t row = base + pc;
                  rs = 1.0f / sqrtf(((F.RS[row] + F.RS[(size_t)M + row]) + (F.RS[(size_t)2 * M + row] + F.RS[(size_t)3 * M + row])) * (1.f / DM) + EPS); }
#endif
#pragma unroll
                for (int j = 0; j < 4; ++j) U[lr * 65 + 16 * j + fr] = ok ? acc[i][j][r] * rs : 0.f; }
        LDS_WAIT(); asm volatile("" ::: "memory");
        const int c = lane & 31, f = f0 + c;
        const float bg = F.conv_b[f], bv = F.conv_b[DFF + f];
        const float g0 = F.conv_w[f], g1 = F.conv_w[NUP + f], g2 = F.conv_w[2 * NUP + f];
        const float w0 = F.conv_w[DFF + f], w1 = F.conv_w[NUP + DFF + f], w2 = F.conv_w[2 * NUP + DFF + f];
        for (int k = 0; k < 31; ++k) { const int lr = 1 + (lane >> 5) + 2 * k, p = R0 - 1 + lr;
            if (p < S) {
                const float cg = bg + g0 * U[(lr - 1) * 65 + c] + g1 * U[lr * 65 + c] + g2 * U[(lr + 1) * 65 + c];
                const float cv = bv + w0 * U[(lr - 1) * 65 + 32 + c] + w1 * U[lr * 65 + 32 + c] + w2 * U[(lr + 1) * 65 + 32 + c];
                const float act = cg / (1.0f + __expf(-cg)) * cv;
                F.ACT[(size_t)(base + p) * DFF + f] = (bf16)f2bf(act); } }
        LDS_WAIT(); asm volatile("" ::: "memory");
    }
}

namespace pg8 {
constexpr int BM = 256, BK = 64, HALF = 128, HTB = HALF * BK * 2, STAGE_BYTES = 8 * HTB, NXCD = 8, WGM = 8;
__host__ __device__ __forceinline__ int lds_byte(int r, int c) { const int st = (r >> 4) * 2 + (c >> 5), rr = r & 15, cc = c & 31, ob = rr * 64 + cc * 2; return st * 1024 + (ob ^ (((ob >> 9) & 1) << 5)); }
__host__ __device__ __forceinline__ void stage_rc(int b, int& R, int& C) { const int st = b / 1024, sb = b % 1024, swz = sb ^ (((sb >> 9) & 1) << 5); R = (st >> 1) * 16 + swz / 64; C = (st & 1) * 32 + (swz % 64) / 2; }
__host__ __device__ __forceinline__ int perm32(int rho) { const int n = rho >> 4, i = rho & 15; return 8 * (i >> 2) + 4 * n + (i & 3); }
struct Unit { int pm, pn; };
struct Gemm { const bf16* A; const bf16* Bt; int lda; int a_pn_off; int M, N, K; };
struct StaticOrder {
    int nM, nN, nwg, G, c;
    __device__ void init(int M_, int N_, int G_, int c_) { nM = M_ / BM; nN = N_ / BM; nwg = nM * nN; G = G_; c = c_; }
    __device__ bool next(int i, Unit& u) const {
        const long L = (long)i * G + c; if (L >= nwg) return false;
        int wgid = (int)L; { const int q = nwg / NXCD, r = nwg % NXCD, xcd = wgid % NXCD, off = wgid / NXCD; wgid = (xcd < r ? xcd * (q + 1) : r * (q + 1) + (xcd - r) * q) + off; }
        const int nig = WGM * nN, gid = wgid / nig, fm = gid * WGM, gsz = (nM - fm) < WGM ? (nM - fm) : WGM;
        u.pm = fm + ((wgid % nig) % gsz); u.pn = (wgid % nig) / gsz; return true;
    }
};
__device__ __forceinline__ unsigned cvt_pk_bf16(float lo, float hi) { unsigned r; asm volatile("v_cvt_pk_bf16_f32 %0, %1, %2" : "=v"(r) : "v"(lo), "v"(hi)); return r; }
#define PG8_EBAR() do { asm volatile("s_waitcnt lgkmcnt(0)" ::: "memory"); __builtin_amdgcn_s_barrier(); asm volatile("" ::: "memory"); } while (0)

typedef f32x4 Acc[2][2][4][2];
__device__ __forceinline__ v4u pack8(const f32x4 a, const f32x4 b) { v4u w; w.x = cvt_pk_bf16(a[0], a[1]); w.y = cvt_pk_bf16(a[2], a[3]); w.z = cvt_pk_bf16(b[0], b[1]); w.w = cvt_pk_bf16(b[2], b[3]); return w; }

struct FEpiZ { static constexpr bool PERM = true, BARRIERS = false; bf16* Z;
    __device__ __forceinline__ void operator()(const Acc& acc, const Unit& u, int wr, int wc, int fr, int fq) const {
        const int row0 = u.pm * BM + wr * 64 + fr, col0 = u.pn * BM + wc * 32 + 8 * fq;
#pragma unroll
        for (int ai = 0; ai < 2; ++ai)
#pragma unroll
            for (int m = 0; m < 4; ++m) { bf16* rowp = Z + (size_t)(row0 + ai * HALF + m * 16) * NZ + col0;
#pragma unroll
                for (int bj = 0; bj < 2; ++bj) *(v4u*)(rowp + bj * HALF) = pack8(acc[ai][bj][m][0], acc[ai][bj][m][1]); } } };
struct FEpiQ { static constexpr bool PERM = false, BARRIERS = false; bf16* Q; const float* COS; const float* SIN;
    __device__ __forceinline__ void operator()(const Acc& acc, const Unit& u, int wr, int wc, int fr, int fq) const {
        int t0, S, base; seqpos(u.pm * BM, t0, S, base);
#pragma unroll
        for (int bj = 0; bj < 2; ++bj) { const int cg = u.pn * BM + bj * HALF + wc * 32; const bool rope = (cg % 96) == 64;
            bf16* p0 = Q + (size_t)(u.pm * BM + wr * 64 + fr) * NQ + cg + 4 * fq;
            if (rope) {
#pragma unroll
                for (int ai = 0; ai < 2; ++ai)
#pragma unroll
                    for (int m = 0; m < 4; ++m) { const int lr = ai * HALF + wr * 64 + m * 16 + fr; const int t = t0 + lr; bf16* p = p0 + (size_t)(ai * HALF + m * 16) * NQ;
                        const f32x4 cs = *(const f32x4*)(COS + t * 16 + 4 * fq), sn = *(const f32x4*)(SIN + t * 16 + 4 * fq);
                        const f32x4 x1 = acc[ai][bj][m][0], x2 = acc[ai][bj][m][1]; const f32x4 o0 = (x1 * cs - x2 * sn) * C2, o1 = (x2 * cs + x1 * sn) * C2;
                        v2u w0, w1; w0.x = cvt_pk_bf16(o0[0], o0[1]); w0.y = cvt_pk_bf16(o0[2], o0[3]); w1.x = cvt_pk_bf16(o1[0], o1[1]); w1.y = cvt_pk_bf16(o1[2], o1[3]);
                        *(v2u*)p = w0; *(v2u*)(p + 16) = w1; }
            } else {
#pragma unroll
                for (int ai = 0; ai < 2; ++ai)
#pragma unroll
                    for (int m = 0; m < 4; ++m) { bf16* p = p0 + (size_t)(ai * HALF + m * 16) * NQ;
                        const f32x4 o0 = acc[ai][bj][m][0] * C2, o1 = acc[ai][bj][m][1] * C2;
                        v2u w0, w1; w0.x = cvt_pk_bf16(o0[0], o0[1]); w0.y = cvt_pk_bf16(o0[2], o0[3]); w1.x = cvt_pk_bf16(o1[0], o1[1]); w1.y = cvt_pk_bf16(o1[2], o1[3]);
                        *(v2u*)p = w0; *(v2u*)(p + 16) = w1; }
            } } } };
struct FEpiKV { static constexpr bool PERM = true, BARRIERS = false; bf16* K; bf16* V;
    __device__ __forceinline__ void operator()(const Acc& acc, const Unit& u, int wr, int wc, int fr, int fq) const {
        const int row0 = u.pm * BM + wr * 64 + fr;
#pragma unroll
        for (int ai = 0; ai < 2; ++ai)
#pragma unroll
            for (int m = 0; m < 4; ++m) { const size_t row = row0 + ai * HALF + m * 16;
#pragma unroll
                for (int bj = 0; bj < 2; ++bj) { const int h = 2 * u.pn + bj; const v4u w = pack8(acc[ai][bj][m][0], acc[ai][bj][m][1]);
                    if (wc < 2) *(v4u*)(K + row * NQ + h * QKD + wc * 32 + 8 * fq) = w; else *(v4u*)(V + row * 512 + h * VD + (wc - 2) * 32 + 8 * fq) = w; } } } };
struct FEpiPool { static constexpr bool PERM = true, BARRIERS = false; bf16* MIX; const float* scale;
    __device__ __forceinline__ void operator()(const Acc& acc, const Unit& u, int wr, int wc, int fr, int fq) const {
        const int row0 = u.pm * BM + wr * 64 + fr, col0 = u.pn * BM + wc * 32 + 8 * fq;
        f32x4 sc[2][2];
#pragma unroll
        for (int bj = 0; bj < 2; ++bj)
#pragma unroll
            for (int n = 0; n < 2; ++n) sc[bj][n] = *(const f32x4*)(scale + col0 + bj * HALF + 4 * n);
#pragma unroll
        for (int ai = 0; ai < 2; ++ai)
#pragma unroll
            for (int m = 0; m < 4; ++m) { bf16* rowp = MIX + (size_t)(row0 + ai * HALF + m * 16) * DM + col0;
#pragma unroll
                for (int bj = 0; bj < 2; ++bj) *(v4u*)(rowp + bj * HALF) = pack8(acc[ai][bj][m][0] * sc[bj][0], acc[ai][bj][m][1] * sc[bj][1]); } } };
struct FEpiWo { static constexpr bool PERM = false, BARRIERS = true; const float* xp; const float* xs; float* out; bf16* H2; const float* g; float* RS;
    __device__ __forceinline__ void run(Acc& acc, const Unit& u, int wr, int wc, int fr, int fq, LAS unsigned char* ldsx, int wid, int lane) const {
        const int r0 = u.pm * BM; const float* xb = r0 < MP ? xp + (size_t)r0 * DM : xs + (size_t)(r0 - MP) * DM;
        const int col0 = u.pn * BM + wc * 32 + 4 * fq;
        LAS float* RSC = (LAS float*)ldsx;
        f32x4 gv[2][2];
#pragma unroll
        for (int bj = 0; bj < 2; ++bj)
#pragma unroll
            for (int n = 0; n < 2; ++n) gv[bj][n] = *(const f32x4*)(g + col0 + bj * HALF + n * 16);
#pragma unroll
        for (int am = 0; am < 4; ++am) { const int ai = am >> 1, mb = (am & 1) * 2;
            f32x4 xv[2][2][2];
#pragma unroll
            for (int mm = 0; mm < 2; ++mm) { const size_t off = (size_t)(ai * HALF + wr * 64 + (mb + mm) * 16 + fr) * DM + col0;
#pragma unroll
                for (int bj = 0; bj < 2; ++bj)
#pragma unroll
                    for (int n = 0; n < 2; ++n) xv[mm][bj][n] = *(const f32x4*)(xb + off + bj * HALF + n * 16); }
#pragma unroll
            for (int mm = 0; mm < 2; ++mm) { const int m = mb + mm; const int lr = ai * HALF + wr * 64 + m * 16 + fr; const size_t off = (size_t)(r0 + lr) * DM + col0; float ss = 0.f;
#pragma unroll
                for (int bj = 0; bj < 2; ++bj)
#pragma unroll
                    for (int n = 0; n < 2; ++n) { const f32x4 x1 = xv[mm][bj][n] + acc[ai][bj][m][n]; *(f32x4*)(out + off + bj * HALF + n * 16) = x1;
                        ss += (x1[0] * x1[0] + x1[1] * x1[1]) + (x1[2] * x1[2] + x1[3] * x1[3]);
                        const f32x4 hv = x1 * gv[bj][n]; v2u w; w.x = cvt_pk_bf16(hv[0], hv[1]); w.y = cvt_pk_bf16(hv[2], hv[3]); *(v2u*)(H2 + off + bj * HALF + n * 16) = w; }
                ss += __shfl_xor(ss, 16); ss += __shfl_xor(ss, 32);
                if (fq == 0) RSC[wc * 256 + lr] = ss; }
            asm volatile("" ::: "memory");
        }
        PG8_EBAR();
        const int tid = wid * 64 + lane;
        if (tid < 256) RS[(size_t)u.pn * M + r0 + tid] = (RSC[tid] + RSC[256 + tid]) + (RSC[512 + tid] + RSC[768 + tid]);
        PG8_EBAR();
    } };
__device__ __forceinline__ float dpp_ror1(float x) { return __builtin_bit_cast(float, __builtin_amdgcn_update_dpp(0, __builtin_bit_cast(int, x), 0x121, 0xf, 0xf, false)); }
__device__ __forceinline__ float dpp_ror15(float x) { return __builtin_bit_cast(float, __builtin_amdgcn_update_dpp(0, __builtin_bit_cast(int, x), 0x12f, 0xf, 0xf, false)); }
__device__ __forceinline__ float silu_mul(float g, float v) { return g * __builtin_amdgcn_rcpf(1.0f + __builtin_amdgcn_exp2f(-1.4426950408889634f * g)) * v; }
struct FEpiUp { static constexpr bool PERM = true, BARRIERS = true; bf16* ACT; const float* RS; const float* conv_w; const float* conv_b; float* EU; float* EC;
    __device__ __forceinline__ void run(Acc& acc, const Unit& u, int wr, int wc, int fr, int fq, LAS unsigned char* ldsx, int wid, int lane) const {
        const int r0 = u.pm * BM;
        LAS float* EDGE = (LAS float*)ldsx;
#pragma unroll
        for (int ai = 0; ai < 2; ++ai)
#pragma unroll
            for (int m = 0; m < 4; ++m) { const size_t row = r0 + ai * HALF + wr * 64 + m * 16 + fr;
                const float ss = (RS[row] + RS[(size_t)M + row]) + (RS[(size_t)2 * M + row] + RS[(size_t)3 * M + row]); const float rs = 1.0f / sqrtf(ss * (1.f / DM) + EPS);
#pragma unroll
                for (int bj = 0; bj < 2; ++bj)
#pragma unroll
                    for (int n = 0; n < 2; ++n) acc[ai][bj][m][n] *= rs;
                if (m & 1) asm volatile("" ::: "memory"); }
        const int lcol = wc * 32 + 8 * fq;
        if (fr == 0) {
#pragma unroll
            for (int ai = 0; ai < 2; ++ai)
#pragma unroll
                for (int bj = 0; bj < 2; ++bj)
#pragma unroll
                    for (int n = 0; n < 2; ++n) *(LAS f32x4*)(EDGE + ((2 * ai + wr) * 2 + 0) * 256 + bj * HALF + lcol + 4 * n) = acc[ai][bj][0][n]; }
        if (fr == 15) {
#pragma unroll
            for (int ai = 0; ai < 2; ++ai)
#pragma unroll
                for (int bj = 0; bj < 2; ++bj)
#pragma unroll
                    for (int n = 0; n < 2; ++n) *(LAS f32x4*)(EDGE + ((2 * ai + wr) * 2 + 1) * 256 + bj * HALF + lcol + 4 * n) = acc[ai][bj][3][n]; }
        PG8_EBAR();
        { const int tid = wid * 64 + lane; if (tid < 256) { EU[((size_t)u.pm * 2 + 0) * NUP + u.pn * 256 + tid] = EDGE[tid]; EU[((size_t)u.pm * 2 + 1) * NUP + u.pn * 256 + tid] = EDGE[7 * 256 + tid]; } }
        typedef float f32x2 __attribute__((ext_vector_type(2)));
        v2u pk0[2][4];
#pragma unroll
        for (int n = 0; n < 2; ++n) { const int fcol = u.pn * HALF + lcol + 4 * n;
            const f32x4 bg = *(const f32x4*)(conv_b + fcol), g0 = *(const f32x4*)(conv_w + fcol), g1 = *(const f32x4*)(conv_w + NUP + fcol), g2 = *(const f32x4*)(conv_w + 2 * NUP + fcol);
            const f32x4 bv = *(const f32x4*)(conv_b + DFF + fcol), v0 = *(const f32x4*)(conv_w + DFF + fcol), v1 = *(const f32x4*)(conv_w + NUP + DFF + fcol), v2 = *(const f32x4*)(conv_w + 2 * NUP + DFF + fcol);
#pragma unroll
            for (int ai = 0; ai < 2; ++ai) { const int s = 2 * ai + wr;
                v2u w[4];
#pragma unroll
                for (int ep = 0; ep < 2; ++ep) {
                    f32x2 eTg = {0.f, 0.f}, eTv = eTg, eBg = eTg, eBv = eTg;
                    if (s > 0) { eTg = *(const LAS f32x2*)(EDGE + ((s - 1) * 2 + 1) * 256 + lcol + 4 * n + 2 * ep); eTv = *(const LAS f32x2*)(EDGE + ((s - 1) * 2 + 1) * 256 + HALF + lcol + 4 * n + 2 * ep); }
                    if (s < 3) { eBg = *(const LAS f32x2*)(EDGE + ((s + 1) * 2 + 0) * 256 + lcol + 4 * n + 2 * ep); eBv = *(const LAS f32x2*)(EDGE + ((s + 1) * 2 + 0) * 256 + HALF + lcol + 4 * n + 2 * ep); }
                    float act[4][2];
#pragma unroll
                    for (int ee = 0; ee < 2; ++ee) { const int e = 2 * ep + ee;
                        float r1[4], r15[4], cg[4], cv[4];
#pragma unroll
                        for (int m = 0; m < 4; ++m) { r1[m] = dpp_ror1(acc[ai][0][m][n][e]); r15[m] = dpp_ror15(acc[ai][0][m][n][e]); }
#pragma unroll
                        for (int m = 0; m < 4; ++m) { const float up = fr == 0 ? (m == 0 ? eTg[ee] : r1[m == 0 ? 0 : m - 1]) : r1[m]; const float dn = fr == 15 ? (m == 3 ? eBg[ee] : r15[m == 3 ? 3 : m + 1]) : r15[m];
                            cg[m] = bg[e] + g0[e] * up + g1[e] * acc[ai][0][m][n][e] + g2[e] * dn; }
#pragma unroll
                        for (int m = 0; m < 4; ++m) { r1[m] = dpp_ror1(acc[ai][1][m][n][e]); r15[m] = dpp_ror15(acc[ai][1][m][n][e]); }
#pragma unroll
                        for (int m = 0; m < 4; ++m) { const float up = fr == 0 ? (m == 0 ? eTv[ee] : r1[m == 0 ? 0 : m - 1]) : r1[m]; const float dn = fr == 15 ? (m == 3 ? eBv[ee] : r15[m == 3 ? 3 : m + 1]) : r15[m];
                            cv[m] = bv[e] + v0[e] * up + v1[e] * acc[ai][1][m][n][e] + v2[e] * dn; }
                        if (ai == 0 && wr == 0 && fr == 0) { float* p = EC + ((size_t)u.pm * 2 + 0) * NUP + u.pn * 256 + lcol + 4 * n + e; p[0] = cg[0]; p[HALF] = cv[0]; }
                        if (ai == 1 && wr == 1 && fr == 15) { float* p = EC + ((size_t)u.pm * 2 + 1) * NUP + u.pn * 256 + lcol + 4 * n + e; p[0] = cg[3]; p[HALF] = cv[3]; }
#pragma unroll
                        for (int m = 0; m < 4; ++m) act[m][ee] = silu_mul(cg[m], cv[m]);
                    }
#pragma unroll
                    for (int m = 0; m < 4; ++m) { const unsigned pw = cvt_pk_bf16(act[m][0], act[m][1]); if (ep == 0) w[m].x = pw; else w[m].y = pw; }
                }
#pragma unroll
                for (int m = 0; m < 4; ++m) {
                    if (n == 0) pk0[ai][m] = w[m];
                    else { v4u o; o.x = pk0[ai][m].x; o.y = pk0[ai][m].y; o.z = w[m].x; o.w = w[m].y;
                        *(v4u*)(ACT + (size_t)(r0 + ai * HALF + wr * 64 + m * 16 + fr) * DFF + u.pn * HALF + lcol) = o; } }
            } }
    } };
struct FEpiDown { static constexpr bool PERM = false, BARRIERS = false; float* out;
    __device__ __forceinline__ void operator()(const Acc& acc, const Unit& u, int wr, int wc, int fr, int fq) const {
        const int col0 = u.pn * BM + wc * 32 + 4 * fq;
#pragma unroll
        for (int ai = 0; ai < 2; ++ai) {
            f32x4 xv[4][2][2];
#pragma unroll
            for (int m = 0; m < 4; ++m) { const size_t off = (size_t)(u.pm * BM + ai * HALF + wr * 64 + m * 16 + fr) * DM + col0;
#pragma unroll
                for (int bj = 0; bj < 2; ++bj)
#pragma unroll
                    for (int n = 0; n < 2; ++n) xv[m][bj][n] = *(const f32x4*)(out + off + bj * HALF + n * 16); }
#pragma unroll
            for (int m = 0; m < 4; ++m) { const size_t off = (size_t)(u.pm * BM + ai * HALF + wr * 64 + m * 16 + fr) * DM + col0;
#pragma unroll
                for (int bj = 0; bj < 2; ++bj)
#pragma unroll
                    for (int n = 0; n < 2; ++n) *(f32x4*)(out + off + bj * HALF + n * 16) = xv[m][bj][n] + acc[ai][bj][m][n]; }
            asm volatile("" ::: "memory");
        } } };

template <class Epi, class Sched>
__device__ __forceinline__ void gemm_phase(LAS unsigned char* lds, LAS unsigned char* ldsx, const Gemm g, const Sched& S, const Epi& E, const int wid) {
    const int lane = lane_id_fresh(), tid = wid * 64 + lane;
    const int  wr = wid >> 2, wc = wid & 3, fr = lane & 15, fq = lane >> 4;
    const int K = g.K, nt = K / BK, lda = g.lda;
    unsigned voffA[2], voffB[2];
#pragma unroll
    for (int i = 0; i < 2; ++i) { int R, C; stage_rc(tid * 16 + i * 8192, R, C); const int Rb = Epi::PERM ? ((R & ~31) + perm32(R & 31)) : R;
        voffA[i] = (unsigned)(R * lda + C) * 2u; voffB[i] = (unsigned)(Rb * K + C) * 2u; }
    const size_t kstep = (size_t)(BK * 2);
    const size_t hstepA = (size_t)HALF * lda * 2, hstepB = (size_t)HALF * K * 2;
    const size_t tstepA = 2 * hstepA, tstepB = 2 * hstepB;
    const unsigned ldsw = (unsigned)wid * 1024u;
    const int aoff = lds_byte(wr * 64 + fr, fq * 8), boff = lds_byte(wc * 32 + fr, fq * 8);
#define PG8_SA(b, h) (((b) * 2 + (h)) * HTB)
#define PG8_SB(b, h) ((4 + (b) * 2 + (h)) * HTB)
#define PG8_STAGE(bufoff, gbase, voff) do { _Pragma("unroll") for (int _i = 0; _i < 2; ++_i) \
        __builtin_amdgcn_global_load_lds((const unsigned*)((const char*)(gbase) + (voff)[_i]), (LAS unsigned*)(lds + (bufoff) + ldsw + _i * 8192), 16, 0, 0); } while (0)
#define PG8_LDA(dst, b, h) do { _Pragma("unroll") for (int m = 0; m < 4; ++m) _Pragma("unroll") for (int k = 0; k < 2; ++k) dst[m][k] = *(const LAS bf16x8*)(lds + PG8_SA(b, h) + aoff + m * 2048 + k * 1024); } while (0)
#define PG8_LDB(dst, b, h) do { _Pragma("unroll") for (int n = 0; n < 2; ++n) _Pragma("unroll") for (int k = 0; k < 2; ++k) dst[n][k] = *(const LAS bf16x8*)(lds + PG8_SB(b, h) + boff + n * 2048 + k * 1024); } while (0)
#define PG8_MMA(ai, bj, At, Bt) do { __builtin_amdgcn_s_setprio(1); _Pragma("unroll") for (int m = 0; m < 4; ++m) _Pragma("unroll") for (int n = 0; n < 2; ++n) _Pragma("unroll") for (int k = 0; k < 2; ++k) \
        acc[ai][bj][m][n] = __builtin_amdgcn_mfma_f32_16x16x32_bf16(Bt[n][k], At[m][k], acc[ai][bj][m][n], 0, 0, 0); __builtin_amdgcn_s_setprio(0); } while (0)
#define PG8_WAIT_V(n) asm volatile("s_waitcnt vmcnt(" #n ")" ::: "memory")
#define PG8_WAIT_L(n) asm volatile("s_waitcnt lgkmcnt(" #n ")" ::: "memory")
#define PG8_BAR __builtin_amdgcn_s_barrier()
#define PG8_SCHED __builtin_amdgcn_sched_barrier(0)
    Unit cur, nxt; int ui = 0;
    if (!S.next(0, cur)) return;
    Acc acc;
#pragma unroll
    for (int a = 0; a < 2; ++a)
#pragma unroll
        for (int b = 0; b < 2; ++b)
#pragma unroll
            for (int m = 0; m < 4; ++m)
#pragma unroll
                for (int n = 0; n < 2; ++n) acc[a][b][m][n] = (f32x4){0.f, 0.f, 0.f, 0.f};
    bf16x8 At[4][2], B0[2][2], B1[2][2];
    const char* cA = (const char*)g.A + (size_t)cur.pm * tstepA + (size_t)cur.pn * g.a_pn_off * 2; const char* cB = (const char*)g.Bt + (size_t)cur.pn * tstepB;
    PG8_STAGE(PG8_SB(0, 0), cB, voffB); PG8_STAGE(PG8_SB(0, 1), cB + hstepB, voffB); PG8_STAGE(PG8_SA(0, 0), cA, voffA); PG8_STAGE(PG8_SA(0, 1), cA + hstepA, voffA);
    if (wr == 1) PG8_BAR;
    PG8_WAIT_V(2); PG8_BAR;
    PG8_STAGE(PG8_SB(1, 0), cB + kstep, voffB); PG8_STAGE(PG8_SA(1, 0), cA + kstep, voffA); PG8_STAGE(PG8_SB(1, 1), cB + hstepB + kstep, voffB);
    PG8_WAIT_V(6); PG8_BAR;
    for (;;) {
        const bool has_next = S.next(ui + 1, nxt);
        const char* nA = has_next ? (const char*)g.A + (size_t)nxt.pm * tstepA + (size_t)nxt.pn * g.a_pn_off * 2 : cA; const char* nB = has_next ? (const char*)g.Bt + (size_t)nxt.pn * tstepB : cB;
        for (int t = 0; t < nt; t += 2) {
            const bool last = (t == nt - 2);
            const char* a1 = cA + (size_t)(t + 1) * kstep;
            const char* a2 = last ? nA : cA + (size_t)(t + 2) * kstep; const char* b2 = last ? nB : cB + (size_t)(t + 2) * kstep;
            const char* a3 = a2 + kstep; const char* b3 = b2 + kstep;
            PG8_LDB(B0, 0, 0); PG8_LDB(B1, 0, 1); PG8_SCHED; PG8_LDA(At, 0, 0); PG8_STAGE(PG8_SA(1, 1), a1 + hstepA, voffA);
            PG8_WAIT_V(8); PG8_WAIT_L(0); PG8_BAR; PG8_MMA(0, 0, At, B0); PG8_MMA(0, 1, At, B1); PG8_BAR; PG8_SCHED;
            PG8_LDA(At, 0, 1); PG8_STAGE(PG8_SB(0, 0), b2, voffB); PG8_STAGE(PG8_SB(0, 1), b2 + hstepB, voffB); PG8_STAGE(PG8_SA(0, 0), a2, voffA);
            PG8_WAIT_V(8); PG8_WAIT_L(0); PG8_BAR; PG8_MMA(1, 0, At, B0); PG8_MMA(1, 1, At, B1); PG8_BAR; PG8_SCHED;
            PG8_LDB(B0, 1, 0); PG8_LDB(B1, 1, 1); PG8_SCHED; PG8_LDA(At, 1, 0); PG8_STAGE(PG8_SA(0, 1), a2 + hstepA, voffA);
            PG8_WAIT_V(8); PG8_WAIT_L(0); PG8_BAR; PG8_MMA(0, 0, At, B0); PG8_MMA(0, 1, At, B1); PG8_BAR; PG8_SCHED;
            PG8_LDA(At, 1, 1); PG8_STAGE(PG8_SB(1, 0), b3, voffB); PG8_STAGE(PG8_SB(1, 1), b3 + hstepB, voffB); PG8_STAGE(PG8_SA(1, 0), a3, voffA);
            PG8_WAIT_V(8); PG8_WAIT_L(0); PG8_BAR; PG8_MMA(1, 0, At, B0); PG8_MMA(1, 1, At, B1); PG8_BAR; PG8_SCHED;
        }
        if (wr == 0) PG8_BAR;
        { const int lane_ = lane_id_fresh(), fr_ = lane_ & 15, fq_ = lane_ >> 4;
          if constexpr (Epi::BARRIERS) E.run(acc, cur, wr, wc, fr_, fq_, ldsx, wid, lane_); else E(acc, cur, wr, wc, fr_, fq_); }
        if (!has_next) break;
#pragma unroll
        for (int a = 0; a < 2; ++a)
#pragma unroll
            for (int b = 0; b < 2; ++b)
#pragma unroll
                for (int m = 0; m < 4; ++m)
#pragma unroll
                    for (int n = 0; n < 2; ++n) acc[a][b][m][n] = (f32x4){0.f, 0.f, 0.f, 0.f};
        cur = nxt; cA = nA; cB = nB; ++ui;
        if (wr == 1) PG8_BAR;
    }
    PG8_WAIT_V(0);
    PG8_BAR;
#undef PG8_SA
#undef PG8_SB
#undef PG8_STAGE
#undef PG8_LDA
#undef PG8_LDB
#undef PG8_MMA
#undef PG8_WAIT_V
#undef PG8_WAIT_L
#undef PG8_BAR
#undef PG8_SCHED
}
}

__device__ __forceinline__ void up_fixup(const Frame& F, const float* EU, const float* EC) {
    const int gt = F.gw * 64 + F.lane, ngt = F.ngw * 64;
    for (int idx = gt; idx < (M / 256) * DFF; idx += ngt) { const int pm = idx / DFF, f = idx - pm * DFF;
        int t0, S, base; seqpos(pm * 256, t0, S, base); if (t0 == 0) continue;
        const int cgc = (f >> 7) * 256 + (f & 127), cvc = cgc + 128;
        const float* euP = EU + ((size_t)(pm - 1) * 2 + 1) * NUP; const float* euN = EU + ((size_t)pm * 2 + 0) * NUP;
        const float* ecP = EC + ((size_t)(pm - 1) * 2 + 1) * NUP; const float* ecN = EC + ((size_t)pm * 2 + 0) * NUP;
        { const float cg = ecN[cgc] + F.conv_w[f] * euP[cgc], cv = ecN[cvc] + F.conv_w[DFF + f] * euP[cvc];
          F.ACT[(size_t)(pm * 256) * DFF + f] = (bf16)f2bf(pg8::silu_mul(cg, cv)); }
        { const float cg = ecP[cgc] + F.conv_w[2 * NUP + f] * euN[cgc], cv = ecP[cvc] + F.conv_w[2 * NUP + DFF + f] * euN[cvc];
          F.ACT[(size_t)(pm * 256 - 1) * DFF + f] = (bf16)f2bf(pg8::silu_mul(cg, cv)); }
    }
}
constexpr int N_PHASES = 11;
__global__ void __launch_bounds__(NWAVES * 64, 2) mega_fwd(Args args) {
    extern __shared__ __attribute__((aligned(16))) unsigned char lds[];
    LAS unsigned char* const ldsb = (LAS unsigned char*)lds;
    const int wave0 = __builtin_amdgcn_readfirstlane((int)threadIdx.x >> 6); const int tid0 = wave0 * 64 + lane_id_fresh();
    unsigned char* ws = args.ws;
    volatile LAS unsigned* MISC = (volatile LAS unsigned*)(ldsb + MISC_OFF);
    for (int u = tid0; u < (LDS_BYTES - MISC_OFF) / 4; u += NWAVES * 64) ((LAS unsigned*)(ldsb + MISC_OFF))[u] = 0u;
    __syncthreads();
    const int lo = args.ph_lo, hi = args.ph_hi;
    XcdBarrier bar; bar.bar = (unsigned*)(ws + WS_CTL) + CW_BAR; bar.x = 0; bar.st = nullptr;
    if (hi - lo > 1) bar = xcd_barrier_post((unsigned*)(ws + WS_CTL) + CW_BAR, MISC + 8, wave0);
#define IN(k) (lo <= (k) && (k) < hi)
#define SEAM(k) do { if (IN(k) && IN((k) + 1)) xcd_barrier(bar, wave0); } while (0)

    LAS unsigned char* const ldsx = ldsb + 131072;
    if (IN(0)) { const Frame F = make_frame(ldsb, wave0); p0_prologue(F); } SEAM(0);
    if (IN(1)) { const Frame F = make_frame(ldsb, wave0);
#if FAST_G1
        pg8::Gemm g{F.HB, F.Win_t, DM, 0, M, NZ, DM}; pg8::StaticOrder S; S.init(M, NZ, F.G, (int)blockIdx.x); pg8::FEpiZ E{F.Z};
        pg8::gemm_phase(F.lds, ldsx, g, S, E, wave0);
#else
        EpiZ E{F.Z}; sgemm(F, F.HB, DM, 0, F.Win_t, DM, M, NZ, E);
#endif
    } SEAM(1);
    if (IN(2)) { const Frame F = make_frame(ldsb, wave0); p2_rows(F); } SEAM(2);
    if (IN(3)) { const Frame F = make_frame(ldsb, wave0);
#if FAST_G2
        { pg8::Gemm g{F.QN, F.Wuq_t, 256, 0, M, NQ, 256}; pg8::StaticOrder S; S.init(M, NQ, F.G, (int)blockIdx.x); pg8::FEpiQ E{F.Q, F.COS, F.SIN}; pg8::gemm_phase(F.lds, ldsx, g, S, E, wave0); }
        { pg8::Gemm g{F.KVN, F.Wukv_t, 128, 0, M, NKV, 128}; pg8::StaticOrder S; S.init(M, NKV, F.G, (int)blockIdx.x); pg8::FEpiKV E{F.K, F.V}; pg8::gemm_phase(F.lds, ldsx, g, S, E, wave0); }
        { pg8::Gemm g{F.POOLED, F.Wpool_t, 512, 256, M, 512, 256}; pg8::StaticOrder S; S.init(M, 512, F.G, (int)blockIdx.x); pg8::FEpiPool E{F.MIX, F.pool_scale}; pg8::gemm_phase(F.lds, ldsx, g, S, E, wave0); }
#else
        { EpiQ E{F.Q, F.COS, F.SIN}; sgemm(F, F.QN, 256, 0, F.Wuq_t, 256, M, NQ, E); }
        { EpiKV E{F.K, F.V}; sgemm(F, F.KVN, 128, 0, F.Wukv_t, 128, M, NKV, E); }
        { EpiPool E{F.MIX, F.pool_scale}; sgemm(F, F.POOLED, 512, 256, F.Wpool_t, 256, M, 512, E); }
#endif
    } SEAM(3);
    if (IN(4)) { const Frame F = make_frame(ldsb, wave0); attn_simple(F); } SEAM(4);
    if (IN(5)) { const Frame F = make_frame(ldsb, wave0);
#if FAST_WO
        pg8::Gemm g{F.MIX, F.Wout_t, DM, 0, M, DM, DM}; pg8::StaticOrder S; S.init(M, DM, F.G, (int)blockIdx.x); pg8::FEpiWo E{F.xp, F.xs, F.out, F.H2, F.g_ffn, F.RS};
        pg8::gemm_phase(F.lds, ldsx, g, S, E, wave0);
#else
        EpiWo E{F.xp, F.xs, F.out}; sgemm(F, F.MIX, DM, 0, F.Wout_t, DM, M, DM, E);
#endif
    } SEAM(5);
    if (IN(6)) { const Frame F = make_frame(ldsb, wave0);
#if !(FAST_WO && DEFER_NORM)
        for (int m = F.gw; m < M; m += F.ngw) rms_row_to_bf16(F, F.out + (size_t)m * DM, F.g_ffn, F.H2 + (size_t)m * DM);
#endif
    } SEAM(6);
    if (IN(7)) { const Frame F = make_frame(ldsb, wave0);
#if FAST_UP
        float* EU = (float*)F.HB; float* EC = EU + (size_t)(M / 256) * 2 * NUP;
        pg8::Gemm g{F.H2, F.Wup_t, DM, 0, M, NUP, DM}; pg8::StaticOrder S; S.init(M, NUP, F.G, (int)blockIdx.x); pg8::FEpiUp E{F.ACT, F.RS, F.conv_w, F.conv_b, EU, EC};
        pg8::gemm_phase(F.lds, ldsx, g, S, E, wave0);
#else
        up_simple(F);
#endif
    } SEAM(7);
    if (IN(8)) {
#if FAST_UP
        const Frame F = make_frame(ldsb, wave0); const float* EU = (const float*)F.HB; up_fixup(F, EU, EU + (size_t)(M / 256) * 2 * NUP);
#endif
    } SEAM(8);
    if (IN(9)) { const Frame F = make_frame(ldsb, wave0);
#if FAST_DOWN
        pg8::Gemm g{F.ACT, F.Wdown_t, DFF, 0, M, DM, DFF}; pg8::StaticOrder S; S.init(M, DM, F.G, (int)blockIdx.x); pg8::FEpiDown E{F.out};
        pg8::gemm_phase(F.lds, ldsx, g, S, E, wave0);
#else
        EpiDown E{F.out}; sgemm(F, F.ACT, DFF, 0, F.Wdown_t, DFF, M, DM, E);
#endif
    }
    SEAM(9);
    if (IN(10)) { const Frame F = make_frame(ldsb, wave0);
        for (int m = F.gw; m < M; m += F.ngw) {
            GAS f32x4* xr = (GAS f32x4*)(F.out + (size_t)m * DM) + F.lane; const GAS f32x4* gr = (const GAS f32x4*)F.g_final + F.lane;
            f32x4 v[4]; float s = 0.f;
#pragma unroll
            for (int j = 0; j < 4; ++j) { v[j] = xr[64 * j]; s += (v[j].x * v[j].x + v[j].y * v[j].y) + (v[j].z * v[j].z + v[j].w * v[j].w); }
            const float rstd = 1.0f / sqrtf(wave_sum(s) * (1.f / DM) + EPS);
#pragma unroll
            for (int j = 0; j < 4; ++j) xr[64 * j] = v[j] * rstd * gr[64 * j];
        }
    }
#undef IN
#undef SEAM
}

extern "C" void kernel_launch(void* const* d_in, const int* in_sizes, int n_in, void* d_out, int out_size, void* d_ws, size_t ws_size, hipStream_t stream) {
    static int grid = 0;
    if (grid == 0) {
        if (n_in != 17 || out_size != M * DM || ws_size < WS_END) { fprintf(stderr, "kernel_launch: unexpected shapes (n_in %d, out %d, ws %zu)\n", n_in, out_size, ws_size); grid = -1; return; }
        int dev = 0, cus = 0, per_cu = 0;
        if (hipGetDevice(&dev) != hipSuccess || hipDeviceGetAttribute(&cus, hipDeviceAttributeMultiprocessorCount, dev) != hipSuccess) { grid = -1; return; }
        if (hipFuncSetAttribute((const void*)mega_fwd, hipFuncAttributeMaxDynamicSharedMemorySize, LDS_BYTES) != hipSuccess) { fprintf(stderr, "kernel_launch: hipFuncSetAttribute failed\n"); grid = -1; return; }
        if (hipOccupancyMaxActiveBlocksPerMultiprocessor(&per_cu, (const void*)mega_fwd, NWAVES * 64, LDS_BYTES) != hipSuccess || per_cu < 1) { fprintf(stderr, "kernel_launch: occupancy query says %d\n", per_cu); per_cu = 1; }
        (void)hipGetLastError();
        grid = cus;
    }
    if (grid < 0) return;
    (void)hipMemsetAsync((char*)d_ws + WS_CTL, 0, CTL_ZERO_BYTES, stream);
    Args a{};
    for (int i = 0; i < 17; ++i) a.in[i] = (const float*)d_in[i];
    a.out = (float*)d_out; a.ws = (unsigned char*)d_ws;
    for (int i = 0; i < 16; ++i) a.freq_rev[i] = std::pow(10000.0, -(double)i / 16.0) / 6.283185307179586476925287;
#if MK_N_LAUNCHES == 1
    a.ph_lo = 0; a.ph_hi = N_PHASES;
    hipLaunchKernelGGL(mega_fwd, dim3(grid), dim3(NWAVES * 64), LDS_BYTES, stream, a);
#else
    for (int p = 0; p < N_PHASES; ++p) { a.ph_lo = p; a.ph_hi = p + 1; hipLaunchKernelGGL(mega_fwd, dim3(grid), dim3(NWAVES * 64), LDS_BYTES, stream, a); }
#endif
}
```

```cpp
#include <hip/hip_runtime.h>
#include <cstdio>
#include <cstdint>
#include <cmath>

#ifndef MK_N_LAUNCHES
#define MK_N_LAUNCHES 1
#endif

#ifndef FAST_G1
#define FAST_G1 1
#endif
#ifndef FAST_G2
#define FAST_G2 1
#endif
#ifndef FAST_WO
#define FAST_WO 1
#endif
#ifndef DEFER_NORM
#define DEFER_NORM 1
#endif
#ifndef FAST_DOWN
#define FAST_DOWN 1
#endif
#ifndef FAST_ATTN
#define FAST_ATTN 1
#endif
#ifndef FAST_UP
#define FAST_UP 1
#endif

#define GAS __attribute__((address_space(1)))
#define LAS __attribute__((address_space(3)))
typedef unsigned short bf16;
typedef short bf16x8 __attribute__((ext_vector_type(8)));
typedef float f32x4 __attribute__((ext_vector_type(4)));
typedef float f32x16 __attribute__((ext_vector_type(16)));
typedef unsigned v4u __attribute__((ext_vector_type(4)));
typedef unsigned v2u __attribute__((ext_vector_type(2)));
typedef GAS unsigned gu32;

constexpr int DM = 1024, MP = 16 * 2048, MS = 2 * 8192, M = MP + MS;
constexpr int SP = 2048, SS = 8192;
constexpr int NZ = 1024;
constexpr int NH = 8, QKD = 96, VD = 64, NQ = NH * QKD  , NKV = NH * 128  ;
constexpr int DFF = 2816, NUP = 2 * DFF;
constexpr float EPS = 1e-6f;
constexpr float C2 = 0.10206207261596577f * 1.4426950408889634f;

constexpr size_t MiB = 1u << 20;
constexpr size_t WS_CTL = 0, CTL_ZERO_BYTES = 1 * MiB;
constexpr size_t WS_WIN = 1 * MiB, WS_WOUT = 3 * MiB, WS_WUQ = 5 * MiB, WS_WUKV = 5 * MiB + 512 * 1024, WS_WPOOL = 6 * MiB, WS_WUP = 7 * MiB, WS_WDOWN = 18 * MiB;
constexpr size_t WS_COS = 23 * MiB + 512 * 1024, WS_SIN = WS_COS + 512 * 1024 / 2 * 2;
constexpr size_t WS_RS = 24 * MiB + 512 * 1024;
constexpr size_t WS_HB = 26 * MiB;
constexpr size_t WS_MIX = WS_HB;
constexpr size_t WS_Z = WS_HB + 96 * MiB;
constexpr size_t WS_H2 = WS_Z;
constexpr size_t WS_POOLED = WS_Z + 96 * MiB;
constexpr size_t WS_QN = WS_POOLED + 48 * MiB;
constexpr size_t WS_KVN = WS_QN + 24 * MiB;
constexpr size_t WS_Q = WS_KVN + 12 * MiB;
constexpr size_t WS_K = WS_Q + 72 * MiB;
constexpr size_t WS_V = WS_K + 72 * MiB;
constexpr size_t WS_ACT = WS_POOLED;
constexpr size_t WS_END = WS_V + 48 * MiB;
static_assert(WS_SIN + 512 * 1024 <= WS_RS && WS_RS + (size_t)4 * M * 4 <= WS_HB, "tables");
static_assert(WS_ACT + (size_t)M * DFF * 2 <= WS_END, "ACT overlay");
static_assert(WS_END <= 512 * MiB, "workspace budget");

constexpr int CW_BAR = 4096;

__device__ __forceinline__ unsigned f2bf(float f) { unsigned u = __builtin_bit_cast(unsigned, f); return (u + 0x7fffu + ((u >> 16) & 1u)) >> 16; }
__device__ __forceinline__ unsigned pk2(float lo, float hi) { return f2bf(lo) | (f2bf(hi) << 16); }
__device__ __forceinline__ float bf2f(unsigned short b) { return __builtin_bit_cast(float, (unsigned)b << 16); }
__device__ __forceinline__ float wave_sum(float v) {
#pragma unroll
    for (int o = 1; o < 64; o <<= 1) v += __shfl_xor(v, o);
    return v;
}
__device__ __forceinline__ int lane_id_fresh() { int l; asm volatile("v_mbcnt_lo_u32_b32 %0, -1, 0\n\tv_mbcnt_hi_u32_b32 %0, -1, %0" : "=v"(l)); return l; }
#define LDS_WAIT() asm volatile("s_waitcnt lgkmcnt(0)" ::: "memory")
#define VM_WAIT() asm volatile("s_waitcnt vmcnt(0)" ::: "memory")

#define XB_TMO      128
#define XB_XCNT(j)  (256  + 64 * (j))
#define XB_XSUB(j)  (1280 + 64 * (j))
#define XB_XGEN(j)  (2304 + 64 * (j))
#define XB_TOP      3328
#define XB_TOPGEN   3392
#define XCD_BAR_WORDS 3456
#define XB_SPIN_CAP (1u << 22)
__device__ __forceinline__ unsigned xb_ld(unsigned* p)              { return __hip_atomic_load(p, __ATOMIC_RELAXED, __HIP_MEMORY_SCOPE_AGENT); }
__device__ __forceinline__ unsigned xb_add(unsigned* p, unsigned v) { return __hip_atomic_fetch_add(p, v, __ATOMIC_RELAXED, __HIP_MEMORY_SCOPE_AGENT); }
__device__ __forceinline__ unsigned xb_xcc_id() { return (unsigned)__builtin_amdgcn_s_getreg((3 << 11) | 20) & 0xFu; }
#define XB_SPIN(cond, bar) do { unsigned _sp = 0; while (cond) { __builtin_amdgcn_s_sleep(1); \
    if ((++_sp & 255u) == 0u) { if (xb_ld(&(bar)[XB_TMO])) break; if (_sp > XB_SPIN_CAP) { atomicAdd(&(bar)[XB_TMO], 1u); break; } } } } while (0)
struct XcdBarrier { unsigned* bar; unsigned x; volatile LAS unsigned* st; };
__device__ __forceinline__ XcdBarrier xcd_barrier_post(unsigned* bar, volatile LAS unsigned* st, int wave) {
    XcdBarrier b; b.bar = bar; b.x = xb_xcc_id(); b.st = st;
    if (wave == 0 && lane_id_fresh() == 0) (void)xb_add(&bar[XB_XCNT(b.x)], 1u);
    return b;
}
__device__ __forceinline__ void xcd_barrier_complete(unsigned* bar, unsigned x, unsigned& nloc, unsigned& nx) {
    const unsigned G = gridDim.x * gridDim.y * gridDim.z;
    unsigned sum, cnt, mine, sp = 0u;
    for (;;) {
        sum = 0u; cnt = 0u; mine = 0u;
#pragma unroll
        for (unsigned j = 0; j < 16; ++j) { const unsigned c = xb_ld(&bar[XB_XCNT(j)]); sum += c; cnt += (c > 0u) ? 1u : 0u; mine = (j == x) ? c : mine; }
        if (sum == G) break;
        __builtin_amdgcn_s_sleep(1);
        if ((++sp & 255u) == 0u) { if (xb_ld(&bar[XB_TMO])) break; if (sp > XB_SPIN_CAP) { atomicAdd(&bar[XB_TMO], 1u); break; } }
    }
    nloc = mine > 0u ? mine : 1u; nx = cnt > 0u ? cnt : 1u;
}
__device__ __forceinline__ void xcd_barrier(const XcdBarrier& b, int wave) {
    asm volatile("s_waitcnt vmcnt(0)" ::: "memory");
    __syncthreads();
    if (wave == 0 && lane_id_fresh() == 0) {
        unsigned* bar = b.bar;
        __builtin_amdgcn_s_waitcnt(0);
        unsigned nloc = b.st[0], nx = b.st[1];
        if (nloc == 0u) { xcd_barrier_complete(bar, b.x, nloc, nx); b.st[0] = nloc; b.st[1] = nx; }
        const unsigned old = xb_add(&bar[XB_XSUB(b.x)], 1u);
        const unsigned gen = old / nloc;
        if (old + 1u == (gen + 1u) * nloc) {
            __builtin_amdgcn_fence(__ATOMIC_RELEASE, "agent");
            asm volatile("s_waitcnt vmcnt(0)" ::: "memory");
            const unsigned og = xb_add(&bar[XB_TOP], 1u);
            const unsigned tg = og / nx;
            if (og + 1u == (tg + 1u) * nx) xb_add(&bar[XB_TOPGEN], 1u);
            else XB_SPIN(xb_ld(&bar[XB_TOPGEN]) == tg, bar);
            __builtin_amdgcn_fence(__ATOMIC_ACQUIRE, "agent");
            xb_add(&bar[XB_XGEN(b.x)], 1u);
            asm volatile("s_waitcnt vmcnt(0)" ::: "memory");
        } else {
            XB_SPIN(xb_ld(&bar[XB_XGEN(b.x)]) == gen, bar);
            __builtin_amdgcn_fence(__ATOMIC_ACQUIRE, "agent");
            asm volatile("s_waitcnt vmcnt(0)" ::: "memory");
        }
    }
    __syncthreads();
}

constexpr int NWAVES = 8;
constexpr int RING_BYTES = 139264;
constexpr int MISC_OFF = RING_BYTES;
constexpr int LDS_BYTES = 147456;

struct Args {
    const float* in[17]; float* out; unsigned char* ws;
    double freq_rev[16];
    int ph_lo, ph_hi;
};
struct Frame {
    const __attribute__((address_space(4))) Args* a;
    LAS unsigned char* lds;
    int tid, lane, wave, gw, ngw, G;
    const float *xp, *xs, *g_mix, *w_in, *g_q, *w_uq, *g_kv, *w_ukv, *w_pool, *pool_scale, *w_out, *g_ffn, *w_up, *conv_w, *conv_b, *w_down, *g_final;
    float* out;
    bf16 *Win_t, *Wout_t, *Wuq_t, *Wukv_t, *Wpool_t, *Wup_t, *Wdown_t;
    float *COS, *SIN, *RS;
    bf16 *HB, *MIX, *Z, *H2, *POOLED, *QN, *KVN, *Q, *K, *V, *ACT;
};
typedef const __attribute__((address_space(4))) Args* CArgs;
__device__ __forceinline__ Frame make_frame(LAS unsigned char* lds, int wave) {
    CArgs a = (CArgs)__builtin_amdgcn_kernarg_segment_ptr(); asm volatile("" : "+s"(a));
    Frame F; F.a = a;
    F.lds = lds;
    F.wave = wave; F.lane = lane_id_fresh(); F.tid = wave * 64 + F.lane;
    F.G = gridDim.x; F.gw = blockIdx.x * NWAVES + F.wave; F.ngw = F.G * NWAVES;
    F.xp = a->in[0]; F.xs = a->in[1]; F.g_mix = a->in[2]; F.w_in = a->in[3]; F.g_q = a->in[4]; F.w_uq = a->in[5]; F.g_kv = a->in[6]; F.w_ukv = a->in[7];
    F.w_pool = a->in[8]; F.pool_scale = a->in[9]; F.w_out = a->in[10]; F.g_ffn = a->in[11]; F.w_up = a->in[12]; F.conv_w = a->in[13]; F.conv_b = a->in[14];
    F.w_down = a->in[15]; F.g_final = a->in[16]; F.out = a->out;
    unsigned char* ws = a->ws;
    F.Win_t = (bf16*)(ws + WS_WIN); F.Wout_t = (bf16*)(ws + WS_WOUT); F.Wuq_t = (bf16*)(ws + WS_WUQ); F.Wukv_t = (bf16*)(ws + WS_WUKV); F.Wpool_t = (bf16*)(ws + WS_WPOOL);
    F.Wup_t = (bf16*)(ws + WS_WUP); F.Wdown_t = (bf16*)(ws + WS_WDOWN); F.COS = (float*)(ws + WS_COS); F.SIN = (float*)(ws + WS_SIN); F.RS = (float*)(ws + WS_RS);
    F.HB = (bf16*)(ws + WS_HB); F.MIX = (bf16*)(ws + WS_MIX); F.Z = (bf16*)(ws + WS_Z); F.H2 = (bf16*)(ws + WS_H2); F.POOLED = (bf16*)(ws + WS_POOLED);
    F.QN = (bf16*)(ws + WS_QN); F.KVN = (bf16*)(ws + WS_KVN); F.Q = (bf16*)(ws + WS_Q); F.K = (bf16*)(ws + WS_K); F.V = (bf16*)(ws + WS_V); F.ACT = (bf16*)(ws + WS_ACT);
    return F;
}
__device__ __forceinline__ const float* xrow(const Frame& F, int m) { return m < MP ? F.xp + (size_t)m * DM : F.xs + (size_t)(m - MP) * DM; }
__device__ __forceinline__ void seqpos(int m, int& t, int& S, int& base) {
    if (m < MP) { S = SP; t = m & (SP - 1); base = m - t; } else { S = SS; t = (m - MP) & (SS - 1); base = m - t; }
}

__device__ __forceinline__ size_t koff(int m, int h, int d) { return ((size_t)((m >> 6) * NH + h) * 12 + (d >> 3)) * 512 + (m & 63) * 8 + (d & 7); }
__device__ __forceinline__ size_t voff(int m, int h, int d) { return ((size_t)((m >> 6) * NH + h) * 2 + (d >> 5)) * 2048 + (m & 63) * 32 + (d & 31); }
__device__ __forceinline__ void transpose_item(const float* W, int K, int N, bf16* WT, int k0, int n0, int drow0, LAS float* scr, int lane) {
#pragma unroll 8
    for (int i = 0; i < 32; ++i) { const int kk = 2 * i + (lane >> 5); scr[kk * 33 + (lane & 31)] = W[(size_t)(k0 + kk) * N + n0 + (lane & 31)]; }
    LDS_WAIT(); asm volatile("" ::: "memory");
    const int c = lane & 7;
#pragma unroll
    for (int j = 0; j < 4; ++j) { const int n = (lane >> 3) + 8 * j; const LAS float* s = scr + (8 * c) * 33 + n;
        v4u o; o.x = pk2(s[0 * 33], s[1 * 33]); o.y = pk2(s[2 * 33], s[3 * 33]); o.z = pk2(s[4 * 33], s[5 * 33]); o.w = pk2(s[6 * 33], s[7 * 33]);
        *(GAS v4u*)(WT + (size_t)(drow0 + n) * K + k0 + 8 * c) = o; }
    LDS_WAIT(); asm volatile("" ::: "memory");
}
__device__ __forceinline__ void rms_row_to_bf16(const Frame& F, const float* xr_, const float* g, bf16* orow) {
    const GAS f32x4* xr = (const GAS f32x4*)xr_ + F.lane; const GAS f32x4* gr = (const GAS f32x4*)g + F.lane;
    f32x4 v[4]; float s = 0.f;
#pragma unroll
    for (int j = 0; j < 4; ++j) { v[j] = xr[64 * j]; s += (v[j].x * v[j].x + v[j].y * v[j].y) + (v[j].z * v[j].z + v[j].w * v[j].w); }
    const float rstd = 1.0f / sqrtf(wave_sum(s) * (1.f / DM) + EPS);
    GAS unsigned long long* o8 = (GAS unsigned long long*)orow + F.lane;
#pragma unroll
    for (int j = 0; j < 4; ++j) { const f32x4 gg = gr[64 * j];
        o8[64 * j] = (unsigned long long)pk2(v[j].x * rstd * gg.x, v[j].y * rstd * gg.y) | ((unsigned long long)pk2(v[j].z * rstd * gg.z, v[j].w * rstd * gg.w) << 32); }
}
__device__ __forceinline__ void p0_prologue(const Frame& F) {
    LAS float* scr = (LAS float*)(F.lds + F.wave * 16384);
    constexpr int I_IN = (1024 / 64) * (928 / 32), I_OUT = (1024 / 64) * (1024 / 32), I_UQ = (256 / 64) * (768 / 32), I_UKV = (128 / 64) * (1024 / 32),
                  I_UP = (1024 / 64) * (NUP / 32), I_DOWN = (DFF / 64) * (1024 / 32);
    constexpr int NITEMS = I_IN + I_OUT + I_UQ + I_UKV + I_UP + I_DOWN;
    for (int it = F.gw; it < NITEMS; it += F.ngw) {
        int r = it;
        if (r < I_IN) { const int nb = 928 / 32, kb = r / nb, n0 = (r % nb) * 32; transpose_item(F.w_in, 1024, 928, F.Win_t, kb * 64, n0, n0, scr, F.lane); continue; } r -= I_IN;
        if (r < I_OUT) { const int nb = 32, kb = r / nb, n0 = (r % nb) * 32; transpose_item(F.w_out, 1024, 1024, F.Wout_t, kb * 64, n0, n0, scr, F.lane); continue; } r -= I_OUT;
        if (r < I_UQ) { const int nb = 768 / 32, kb = r / nb, n0 = (r % nb) * 32; transpose_item(F.w_uq, 256, 768, F.Wuq_t, kb * 64, n0, n0, scr, F.lane); continue; } r -= I_UQ;
        if (r < I_UKV) { const int nb = 32, kb = r / nb, n0 = (r % nb) * 32; transpose_item(F.w_ukv, 128, 1024, F.Wukv_t, kb * 64, n0, n0, scr, F.lane); continue; } r -= I_UKV;
        if (r < I_UP) { const int nb = NUP / 32, kb = r / nb, n0 = (r % nb) * 32;
            const int f = n0 < DFF ? n0 : n0 - DFF; const int drow = 256 * (f / 128) + (n0 < DFF ? 0 : 128) + (f % 128);
            transpose_item(F.w_up, 1024, NUP, F.Wup_t, kb * 64, n0, drow, scr, F.lane); continue; } r -= I_UP;
        { const int nb = 32, kb = r / nb, n0 = (r % nb) * 32; transpose_item(F.w_down, DFF, 1024, F.Wdown_t, kb * 64, n0, n0, scr, F.lane); }
    }
    const int gt = F.gw * 64 + F.lane, ngt = F.ngw * 64;
    for (int i = gt; i < 96 * 1024 / 2; i += ngt) ((GAS unsigned*)(F.Win_t + 928 * 1024))[i] = 0u;
    for (int i = gt; i < 512 * 256; i += ngt) { const int n = i >> 8, k = i & 255; const int g = n >> 7, d = n & 127, pc = 256 * (n >> 8) + k, gp = pc >> 7;
        const float w = (gp == g) ? F.w_pool[((size_t)g * 128 + (pc & 127)) * 128 + d] : 0.f; F.Wpool_t[i] = (bf16)f2bf(w); }
    for (int i = gt; i < SS * 16; i += ngt) { const int t = i >> 4, j = i & 15; const double rev = (double)t * F.a->freq_rev[j]; const float fr = (float)(rev - floor(rev));
        F.COS[i] = __builtin_amdgcn_cosf(fr); F.SIN[i] = __builtin_amdgcn_sinf(fr); }
    for (int m = F.gw; m < M; m += F.ngw) rms_row_to_bf16(F, xrow(F, m), F.g_mix, F.HB + (size_t)m * DM);
}

template <class Epi>
__device__ __forceinline__ void sgemm(const Frame& F, const bf16* A, int lda, int a_noff, const bf16* Bt, int K, int Mr, int N, const Epi& E) {
    const int fr = F.lane & 15, fq = F.lane >> 4;
    const int tn = N / 64, tiles = (Mr / 64) * tn;
    for (int tile = F.gw; tile < tiles; tile += F.ngw) {
        const int r0 = (tile / tn) * 64, c0 = (tile % tn) * 64;
        f32x4 acc[4][4];
#pragma unroll
        for (int i = 0; i < 4; ++i)
#pragma unroll
            for (int j = 0; j < 4; ++j) acc[i][j] = (f32x4){0.f, 0.f, 0.f, 0.f};
        const bf16* Ab = A + (size_t)(r0 + fr) * lda + (c0 / 256) * a_noff + fq * 8;
        const bf16* Bb = Bt + (size_t)(c0 + fr) * K + fq * 8;
        for (int k0 = 0; k0 < K; k0 += 32) {
            bf16x8 a[4], b[4];
#pragma unroll
            for (int i = 0; i < 4; ++i) a[i] = *(const bf16x8*)(Ab + (size_t)i * 16 * lda + k0);
#pragma unroll
            for (int j = 0; j < 4; ++j) b[j] = *(const bf16x8*)(Bb + (size_t)j * 16 * K + k0);
#pragma unroll
            for (int i = 0; i < 4; ++i)
#pragma unroll
                for (int j = 0; j < 4; ++j) acc[i][j] = __builtin_amdgcn_mfma_f32_16x16x32_bf16(a[i], b[j], acc[i][j], 0, 0, 0);
        }
        E(acc, r0, c0, fr, fq);
    }
}
struct EpiZ { bf16* Z;
    __device__ __forceinline__ void operator()(const f32x4 (&acc)[4][4], int r0, int c0, int fr, int fq) const {
#pragma unroll
        for (int i = 0; i < 4; ++i)
#pragma unroll
            for (int r = 0; r < 4; ++r) { const size_t row = r0 + 16 * i + 4 * fq + r;
#pragma unroll
                for (int j = 0; j < 4; ++j) Z[row * NZ + c0 + 16 * j + fr] = (bf16)f2bf(acc[i][j][r]); } } };
struct EpiQ { bf16* Q; const float* COS; const float* SIN;
    __device__ __forceinline__ void operator()(const f32x4 (&acc)[4][4], int r0, int c0, int fr, int fq) const {
#pragma unroll
        for (int i = 0; i < 4; ++i)
#pragma unroll
            for (int r = 0; r < 4; ++r) { const int row = r0 + 16 * i + 4 * fq + r; int t, S, base; seqpos(row, t, S, base);
                const float cs = COS[t * 16 + fr], sn = SIN[t * 16 + fr];
#pragma unroll
                for (int j = 0; j < 4; ++j) { const int blk = ((c0 >> 4) + j) % 6; const size_t o = (size_t)row * NQ + c0 + 16 * j + fr;
                    if (blk < 4) Q[o] = (bf16)f2bf(acc[i][j][r] * C2);
                    else if (blk == 4) { if (j < 3) { const float x1 = acc[i][j][r], x2 = acc[i][j < 3 ? j + 1 : j][r];
                        Q[o] = (bf16)f2bf((x1 * cs - x2 * sn) * C2); Q[o + 16] = (bf16)f2bf((x2 * cs + x1 * sn) * C2); } } } } } };
struct EpiKV { bf16* K; bf16* V;
    __device__ __forceinline__ void operator()(const f32x4 (&acc)[4][4], int r0, int c0, int fr, int fq) const {
#pragma unroll
        for (int i = 0; i < 4; ++i)
#pragma unroll
            for (int r = 0; r < 4; ++r) { const size_t row = r0 + 16 * i + 4 * fq + r;
#pragma unroll
                for (int j = 0; j < 4; ++j) { const int col = c0 + 16 * j + fr, h = col >> 7, d = col & 127;
                    if (d < 64) K[koff((int)row, h, d)] = (bf16)f2bf(acc[i][j][r]); else V[voff((int)row, h, d - 64)] = (bf16)f2bf(acc[i][j][r]); } } } };
struct EpiPool { bf16* MIX; const float* scale;
    __device__ __forceinline__ void operator()(const f32x4 (&acc)[4][4], int r0, int c0, int fr, int fq) const {
#pragma unroll
        for (int j = 0; j < 4; ++j) { const int col = c0 + 16 * j + fr; const float sc = scale[col];
#pragma unroll
            for (int i = 0; i < 4; ++i)
#pragma unroll
                for (int r = 0; r < 4; ++r) { const size_t row = r0 + 16 * i + 4 * fq + r; MIX[row * DM + col] = (bf16)f2bf(acc[i][j][r] * sc); } } } };
struct EpiWo { const float* xp; const float* xs; float* out;
    __device__ __forceinline__ void operator()(const f32x4 (&acc)[4][4], int r0, int c0, int fr, int fq) const {
        const float* xb = r0 < MP ? xp + (size_t)r0 * DM : xs + (size_t)(r0 - MP) * DM;
#pragma unroll
        for (int i = 0; i < 4; ++i)
#pragma unroll
            for (int r = 0; r < 4; ++r) { const size_t lr = 16 * i + 4 * fq + r;
#pragma unroll
                for (int j = 0; j < 4; ++j) { const int col = c0 + 16 * j + fr; out[(size_t)(r0 + lr) * DM + col] = xb[lr * DM + col] + acc[i][j][r]; } } } };
struct EpiDown { float* out;
    __device__ __forceinline__ void operator()(const f32x4 (&acc)[4][4], int r0, int c0, int fr, int fq) const {
#pragma unroll
        for (int i = 0; i < 4; ++i)
#pragma unroll
            for (int r = 0; r < 4; ++r) { const size_t row = r0 + 16 * i + 4 * fq + r;
#pragma unroll
                for (int j = 0; j < 4; ++j) { const int col = c0 + 16 * j + fr; out[row * DM + col] += acc[i][j][r]; } } } };

__device__ __forceinline__ void p2_rows(const Frame& F) {
    const int lane = F.lane;
    for (int m = F.gw; m < M; m += F.ngw) {
        int t, S, base; seqpos(m, t, S, base);
        const bf16* zr = F.Z + (size_t)m * NZ;
        { const v2u w = *(const GAS v2u*)(zr + 512 + 4 * lane); float v0 = bf2f(w.x & 0xffff), v1 = bf2f(w.x >> 16), v2 = bf2f(w.y & 0xffff), v3 = bf2f(w.y >> 16);
          const float rstd = 1.0f / sqrtf(wave_sum((v0 * v0 + v1 * v1) + (v2 * v2 + v3 * v3)) * (1.f / 256.f) + EPS);
          const f32x4 g = *(const GAS f32x4*)(F.g_q + 4 * lane);
          v2u o; o.x = pk2(v0 * rstd * g.x, v1 * rstd * g.y); o.y = pk2(v2 * rstd * g.z, v3 * rstd * g.w); *(GAS v2u*)(F.QN + (size_t)m * 256 + 4 * lane) = o; }
        { const unsigned w = *(const GAS unsigned*)(zr + 768 + 2 * lane); float v0 = bf2f(w & 0xffff), v1 = bf2f(w >> 16);
          const float rstd = 1.0f / sqrtf(wave_sum(v0 * v0 + v1 * v1) * (1.f / 128.f) + EPS);
          *(GAS unsigned*)(F.KVN + (size_t)m * 128 + 2 * lane) = pk2(v0 * rstd * F.g_kv[2 * lane], v1 * rstd * F.g_kv[2 * lane + 1]); }
        { const int i = lane & 15; const float x1 = bf2f(zr[896 + i]), x2 = bf2f(zr[912 + i]); const float cs = F.COS[t * 16 + i], sn = F.SIN[t * 16 + i];
          const float o = (lane & 16) ? (x2 * cs + x1 * sn) : (x1 * cs - x2 * sn);
          const unsigned short ob = (unsigned short)f2bf(o); const int d = lane & 31;
#pragma unroll
          for (int hh = 0; hh < 4; ++hh) { const int h = 2 * hh + (lane >> 5); F.K[koff(m, h, 64 + d)] = ob; } }
        { const int g = lane >> 4, w = 2 << g; const int lo = (t - w / 2) < 0 ? 0 : t - w / 2, hi = (t + w / 2) > S ? S : t + w / 2;
          float s[8];
#pragma unroll
          for (int e = 0; e < 8; ++e) s[e] = 0.f;
          for (int tt = lo; tt < hi; ++tt) { const v4u u = *(const GAS v4u*)(F.Z + (size_t)(base + tt) * NZ + 8 * lane);
              s[0] += bf2f(u.x & 0xffff); s[1] += bf2f(u.x >> 16); s[2] += bf2f(u.y & 0xffff); s[3] += bf2f(u.y >> 16);
              s[4] += bf2f(u.z & 0xffff); s[5] += bf2f(u.z >> 16); s[6] += bf2f(u.w & 0xffff); s[7] += bf2f(u.w >> 16); }
          const float inv = 1.0f / (float)(hi - lo);
          const v4u u = *(const GAS v4u*)(zr + 8 * lane);
          v4u o; o.x = pk2(s[0] * inv - bf2f(u.x & 0xffff), s[1] * inv - bf2f(u.x >> 16)); o.y = pk2(s[2] * inv - bf2f(u.y & 0xffff), s[3] * inv - bf2f(u.y >> 16));
          o.z = pk2(s[4] * inv - bf2f(u.z & 0xffff), s[5] * inv - bf2f(u.z >> 16)); o.w = pk2(s[6] * inv - bf2f(u.w & 0xffff), s[7] * inv - bf2f(u.w >> 16));
          *(GAS v4u*)(F.POOLED + (size_t)m * 512 + 8 * lane) = o; }
    }
}

__device__ __forceinline__ int crow(int r, int hi) { return (r & 3) + 8 * (r >> 2) + 4 * hi; }
__device__ __forceinline__ void attn_simple(const Frame& F) {
    const int lane = F.lane, r32 = lane & 31, hi = lane >> 5;
    constexpr int UP_ = MP / 32 * NH, US_ = MS / 32 * NH;
    for (int u = F.gw; u < UP_ + US_; u += F.ngw) {
        int q0, h;
        if (u < US_) { h = u % NH; q0 = MP + (u / NH) * 32; } else { const int v = u - US_; h = v % NH; q0 = (v / NH) * 32; }
        int t, S, base; seqpos(q0, t, S, base);
        bf16x8 qf[6];
#pragma unroll
        for (int s = 0; s < 6; ++s) qf[s] = *(const bf16x8*)(F.Q + (size_t)(q0 + r32) * NQ + h * QKD + 16 * s + 8 * hi);
        f32x16 o0 = {}, o1 = {};
        float mrun = -1e30f, lrun = 0.f;
        for (int kv0 = 0; kv0 < S; kv0 += 32) {
            f32x16 x = {};
#pragma unroll
            for (int s = 0; s < 6; ++s) { const bf16x8 kf = *(const bf16x8*)(F.K + koff(base + kv0 + r32, h, 16 * s + 8 * hi)); x = __builtin_amdgcn_mfma_f32_32x32x16_bf16(kf, qf[s], x, 0, 0, 0); }
            float mx = x[0];
#pragma unroll
            for (int r = 1; r < 16; ++r) mx = fmaxf(mx, x[r]);
            mx = fmaxf(mx, __shfl_xor(mx, 32));
            const float mnew = fmaxf(mrun, mx), alpha = __builtin_amdgcn_exp2f(mrun - mnew);
            float ls = 0.f;
#pragma unroll
            for (int r = 0; r < 16; ++r) { x[r] = __builtin_amdgcn_exp2f(x[r] - mnew); ls += x[r]; }
            ls += __shfl_xor(ls, 32);
            lrun = lrun * alpha + ls; mrun = mnew;
#pragma unroll
            for (int r = 0; r < 16; ++r) { const float a = __shfl(alpha, crow(r, hi)); o0[r] *= a; o1[r] *= a; }
#pragma unroll
            for (int s = 0; s < 2; ++s) {
                bf16x8 pa;
#pragma unroll
                for (int j = 0; j < 8; ++j) pa[j] = (short)f2bf(x[8 * s + j]);
                bf16x8 v0, v1;
#pragma unroll
                for (int j = 0; j < 8; ++j) { const int kvm = base + kv0 + crow(8 * s + j, hi); v0[j] = (short)F.V[voff(kvm, h, r32)]; v1[j] = (short)F.V[voff(kvm, h, 32 + r32)]; }
                o0 = __builtin_amdgcn_mfma_f32_32x32x16_bf16(pa, v0, o0, 0, 0, 0);
                o1 = __builtin_amdgcn_mfma_f32_32x32x16_bf16(pa, v1, o1, 0, 0, 0);
            }
        }
        const float linv = 1.0f / lrun;
#pragma unroll
        for (int r = 0; r < 16; ++r) { const float li = __shfl(linv, crow(r, hi)); const size_t row = q0 + crow(r, hi);
            F.MIX[row * DM + 512 + h * VD + r32] = (bf16)f2bf(o0[r] * li); F.MIX[row * DM + 512 + h * VD + 32 + r32] = (bf16)f2bf(o1[r] * li); }
    }
}

__device__ __forceinline__ void up_simple(const Frame& F) {
    const int lane = F.lane, fr = lane & 15, fq = lane >> 4;
    LAS float* U = (LAS float*)(F.lds + F.wave * 16640);
    constexpr int RT_P = (SP + 61) / 62, RT_S = (SS + 61) / 62, NRT = 16 * RT_P + 2 * RT_S, NFT = DFF / 32;
    for (int tile = F.gw; tile < NRT * NFT; tile += F.ngw) {
        const int rt = tile / NFT, f0 = (tile % NFT) * 32;
        int base, S, R0;
        if (rt < 16 * RT_P) { base = (rt / RT_P) * SP; S = SP; R0 = (rt % RT_P) * 62; } else { const int q = rt - 16 * RT_P; base = MP + (q / RT_S) * SS; S = SS; R0 = (q % RT_S) * 62; }
        f32x4 acc[4][4];
#pragma unroll
        for (int i = 0; i < 4; ++i)
#pragma unroll
            for (int j = 0; j < 4; ++j) acc[i][j] = (f32x4){0.f, 0.f, 0.f, 0.f};
        const bf16* ap[4];
#pragma unroll
        for (int i = 0; i < 4; ++i) { int p = R0 - 1 + 16 * i + fr; p = p < 0 ? 0 : (p >= S ? S - 1 : p); ap[i] = F.H2 + (size_t)(base + p) * DM + fq * 8; }
        const bf16* bp[4];
#pragma unroll
        for (int j = 0; j < 4; ++j) { const int f = f0 + 16 * (j & 1) + fr; const int drow = 256 * (f / 128) + (j >> 1) * 128 + (f % 128); bp[j] = F.Wup_t + (size_t)drow * DM + fq * 8; }
        for (int k0 = 0; k0 < DM; k0 += 32) {
            bf16x8 a[4], b[4];
#pragma unroll
            for (int i = 0; i < 4; ++i) a[i] = *(const bf16x8*)(ap[i] + k0);
#pragma unroll
            for (int j = 0; j < 4; ++j) b[j] = *(const bf16x8*)(bp[j] + k0);
#pragma unroll
            for (int i = 0; i < 4; ++i)
#pragma unroll
                for (int j = 0; j < 4; ++j) acc[i][j] = __builtin_amdgcn_mfma_f32_16x16x32_bf16(a[i], b[j], acc[i][j], 0, 0, 0);
        }
#pragma unroll
        for (int i = 0; i < 4; ++i)
#pragma unroll
            for (int r = 0; r < 4; ++r) { const int lr = 16 * i + 4 * fq + r, p = R0 - 1 + lr; const bool ok = (p >= 0) && (p < S);
                float rs = 1.f;
#if DEFER_NORM
                { const int pc = p < 0 ? 0 : (p >= S ? S - 1 : p); const size_t row = base + pc;
                  rs = 1.0f / sqrtf(((F.RS[row] + F.RS[(size_t)M + row]) + (F.RS[(size_t)2 * M + row] + F.RS[(size_t)3 * M + row])) * (1.f / DM) + EPS); }
#endif
#pragma unroll
                for (int j = 0; j < 4; ++j) U[lr * 65 + 16 * j + fr] = ok ? acc[i][j][r] * rs : 0.f; }
        LDS_WAIT(); asm volatile("" ::: "memory");
        const int c = lane & 31, f = f0 + c;
        const float bg = F.conv_b[f], bv = F.conv_b[DFF + f];
        const float g0 = F.conv_w[f], g1 = F.conv_w[NUP + f], g2 = F.conv_w[2 * NUP + f];
        const float w0 = F.conv_w[DFF + f], w1 = F.conv_w[NUP + DFF + f], w2 = F.conv_w[2 * NUP + DFF + f];
        for (int k = 0; k < 31; ++k) { const int lr = 1 + (lane >> 5) + 2 * k, p = R0 - 1 + lr;
            if (p < S) {
                const float cg = bg + g0 * U[(lr - 1) * 65 + c] + g1 * U[lr * 65 + c] + g2 * U[(lr + 1) * 65 + c];
                const float cv = bv + w0 * U[(lr - 1) * 65 + 32 + c] + w1 * U[lr * 65 + 32 + c] + w2 * U[(lr + 1) * 65 + 32 + c];
                const float act = cg / (1.0f + __expf(-cg)) * cv;
                F.ACT[(size_t)(base + p) * DFF + f] = (bf16)f2bf(act); } }
        LDS_WAIT(); asm volatile("" ::: "memory");
    }
}

namespace pg8 {
constexpr int BM = 256, BK = 64, HALF = 128, HTB = HALF * BK * 2, STAGE_BYTES = 8 * HTB, NXCD = 8, WGM = 8;
__host__ __device__ __forceinline__ int lds_byte(int r, int c) { const int st = (r >> 4) * 2 + (c >> 5), rr = r & 15, cc = c & 31, ob = rr * 64 + cc * 2; return st * 1024 + (ob ^ (((ob >> 9) & 1) << 5)); }
__host__ __device__ __forceinline__ void stage_rc(int b, int& R, int& C) { const int st = b / 1024, sb = b % 1024, swz = sb ^ (((sb >> 9) & 1) << 5); R = (st >> 1) * 16 + swz / 64; C = (st & 1) * 32 + (swz % 64) / 2; }
__host__ __device__ __forceinline__ int perm32(int rho) { const int n = rho >> 4, i = rho & 15; return 8 * (i >> 2) + 4 * n + (i & 3); }
struct Unit { int pm, pn; };
struct Gemm { const bf16* A; const bf16* Bt; int lda; int a_pn_off; int M, N, K; };
struct StaticOrder {
    int nM, nN, nwg, G, c;
    __device__ void init(int M_, int N_, int G_, int c_) { nM = M_ / BM; nN = N_ / BM; nwg = nM * nN; G = G_; c = c_; }
    __device__ bool next(int i, Unit& u) const {
        const long L = (long)i * G + c; if (L >= nwg) return false;
        int wgid = (int)L; { const int q = nwg / NXCD, r = nwg % NXCD, xcd = wgid % NXCD, off = wgid / NXCD; wgid = (xcd < r ? xcd * (q + 1) : r * (q + 1) + (xcd - r) * q) + off; }
        const int nig = WGM * nN, gid = wgid / nig, fm = gid * WGM, gsz = (nM - fm) < WGM ? (nM - fm) : WGM;
        u.pm = fm + ((wgid % nig) % gsz); u.pn = (wgid % nig) / gsz; return true;
    }
};
__device__ __forceinline__ unsigned cvt_pk_bf16(float lo, float hi) { unsigned r; asm volatile("v_cvt_pk_bf16_f32 %0, %1, %2" : "=v"(r) : "v"(lo), "v"(hi)); return r; }
#define PG8_EBAR() do { asm volatile("s_waitcnt lgkmcnt(0)" ::: "memory"); __builtin_amdgcn_s_barrier(); asm volatile("" ::: "memory"); } while (0)

typedef f32x4 Acc[2][2][4][2];
__device__ __forceinline__ v4u pack8(const f32x4 a, const f32x4 b) { v4u w; w.x = cvt_pk_bf16(a[0], a[1]); w.y = cvt_pk_bf16(a[2], a[3]); w.z = cvt_pk_bf16(b[0], b[1]); w.w = cvt_pk_bf16(b[2], b[3]); return w; }

struct FEpiZ { static constexpr bool PERM = true, BARRIERS = false; bf16* Z;
    __device__ __forceinline__ void operator()(const Acc& acc, const Unit& u, int wr, int wc, int fr, int fq) const {
        const int row0 = u.pm * BM + wr * 64 + fr, col0 = u.pn * BM + wc * 32 + 8 * fq;
#pragma unroll
        for (int ai = 0; ai < 2; ++ai)
#pragma unroll
            for (int m = 0; m < 4; ++m) { bf16* rowp = Z + (size_t)(row0 + ai * HALF + m * 16) * NZ + col0;
#pragma unroll
                for (int bj = 0; bj < 2; ++bj) *(v4u*)(rowp + bj * HALF) = pack8(acc[ai][bj][m][0], acc[ai][bj][m][1]); } } };
struct FEpiQ { static constexpr bool PERM = false, BARRIERS = false; bf16* Q; const float* COS; const float* SIN;
    __device__ __forceinline__ void operator()(const Acc& acc, const Unit& u, int wr, int wc, int fr, int fq) const {
        int t0, S, base; seqpos(u.pm * BM, t0, S, base);
#pragma unroll
        for (int bj = 0; bj < 2; ++bj) { const int cg = u.pn * BM + bj * HALF + wc * 32; const bool rope = (cg % 96) == 64;
            bf16* p0 = Q + (size_t)(u.pm * BM + wr * 64 + fr) * NQ + cg + 4 * fq;
            if (rope) {
#pragma unroll
                for (int ai = 0; ai < 2; ++ai)
#pragma unroll
                    for (int m = 0; m < 4; ++m) { const int lr = ai * HALF + wr * 64 + m * 16 + fr; const int t = t0 + lr; bf16* p = p0 + (size_t)(ai * HALF + m * 16) * NQ;
                        const f32x4 cs = *(const f32x4*)(COS + t * 16 + 4 * fq), sn = *(const f32x4*)(SIN + t * 16 + 4 * fq);
                        const f32x4 x1 = acc[ai][bj][m][0], x2 = acc[ai][bj][m][1]; const f32x4 o0 = (x1 * cs - x2 * sn) * C2, o1 = (x2 * cs + x1 * sn) * C2;
                        v2u w0, w1; w0.x = cvt_pk_bf16(o0[0], o0[1]); w0.y = cvt_pk_bf16(o0[2], o0[3]); w1.x = cvt_pk_bf16(o1[0], o1[1]); w1.y = cvt_pk_bf16(o1[2], o1[3]);
                        *(v2u*)p = w0; *(v2u*)(p + 16) = w1; }
            } else {
#pragma unroll
                for (int ai = 0; ai < 2; ++ai)
#pragma unroll
                    for (int m = 0; m < 4; ++m) { bf16* p = p0 + (size_t)(ai * HALF + m * 16) * NQ;
                        const f32x4 o0 = acc[ai][bj][m][0] * C2, o1 = acc[ai][bj][m][1] * C2;
                        v2u w0, w1; w0.x = cvt_pk_bf16(o0[0], o0[1]); w0.y = cvt_pk_bf16(o0[2], o0[3]); w1.x = cvt_pk_bf16(o1[0], o1[1]); w1.y = cvt_pk_bf16(o1[2], o1[3]);
                        *(v2u*)p = w0; *(v2u*)(p + 16) = w1; }
            } } } };
struct FEpiKV { static constexpr bool PERM = true, BARRIERS = false; bf16* K; bf16* V;
    __device__ __forceinline__ void operator()(const Acc& acc, const Unit& u, int wr, int wc, int fr, int fq) const {
        const int row0 = u.pm * BM + wr * 64 + fr;
#pragma unroll
        for (int ai = 0; ai < 2; ++ai)
#pragma unroll
            for (int m = 0; m < 4; ++m) { const size_t row = row0 + ai * HALF + m * 16;
#pragma unroll
                for (int bj = 0; bj < 2; ++bj) { const int h = 2 * u.pn + bj; const v4u w = pack8(acc[ai][bj][m][0], acc[ai][bj][m][1]);
                    if (wc < 2) *(v4u*)(K + koff((int)row, h, wc * 32 + 8 * fq)) = w; else *(v4u*)(V + voff((int)row, h, (wc - 2) * 32 + 8 * fq)) = w; } } } };
struct FEpiPool { static constexpr bool PERM = true, BARRIERS = false; bf16* MIX; const float* scale;
    __device__ __forceinline__ void operator()(const Acc& acc, const Unit& u, int wr, int wc, int fr, int fq) const {
        const int row0 = u.pm * BM + wr * 64 + fr, col0 = u.pn * BM + wc * 32 + 8 * fq;
        f32x4 sc[2][2];
#pragma unroll
        for (int bj = 0; bj < 2; ++bj)
#pragma unroll
            for (int n = 0; n < 2; ++n) sc[bj][n] = *(const f32x4*)(scale + col0 + bj * HALF + 4 * n);
#pragma unroll
        for (int ai = 0; ai < 2; ++ai)
#pragma unroll
            for (int m = 0; m < 4; ++m) { bf16* rowp = MIX + (size_t)(row0 + ai * HALF + m * 16) * DM + col0;
#pragma unroll
                for (int bj = 0; bj < 2; ++bj) *(v4u*)(rowp + bj * HALF) = pack8(acc[ai][bj][m][0] * sc[bj][0], acc[ai][bj][m][1] * sc[bj][1]); } } };
struct FEpiWo { static constexpr bool PERM = false, BARRIERS = true; const float* xp; const float* xs; float* out; bf16* H2; const float* g; float* RS;
    __device__ __forceinline__ void run(Acc& acc, const Unit& u, int wr, int wc, int fr, int fq, LAS unsigned char* ldsx, int wid, int lane) const {
        const int r0 = u.pm * BM; const float* xb = r0 < MP ? xp + (size_t)r0 * DM : xs + (size_t)(r0 - MP) * DM;
        const int col0 = u.pn * BM + wc * 32 + 4 * fq;
        LAS float* RSC = (LAS float*)ldsx;
        f32x4 gv[2][2];
#pragma unroll
        for (int bj = 0; bj < 2; ++bj)
#pragma unroll
            for (int n = 0; n < 2; ++n) gv[bj][n] = *(const f32x4*)(g + col0 + bj * HALF + n * 16);
#pragma unroll
        for (int am = 0; am < 4; ++am) { const int ai = am >> 1, mb = (am & 1) * 2;
            f32x4 xv[2][2][2];
#pragma unroll
            for (int mm = 0; mm < 2; ++mm) { const size_t off = (size_t)(ai * HALF + wr * 64 + (mb + mm) * 16 + fr) * DM + col0;
#pragma unroll
                for (int bj = 0; bj < 2; ++bj)
#pragma unroll
                    for (int n = 0; n < 2; ++n) xv[mm][bj][n] = *(const f32x4*)(xb + off + bj * HALF + n * 16); }
#pragma unroll
            for (int mm = 0; mm < 2; ++mm) { const int m = mb + mm; const int lr = ai * HALF + wr * 64 + m * 16 + fr; const size_t off = (size_t)(r0 + lr) * DM + col0; float ss = 0.f;
#pragma unroll
                for (int bj = 0; bj < 2; ++bj)
#pragma unroll
                    for (int n = 0; n < 2; ++n) { const f32x4 x1 = xv[mm][bj][n] + acc[ai][bj][m][n]; *(f32x4*)(out + off + bj * HALF + n * 16) = x1;
                        ss += (x1[0] * x1[0] + x1[1] * x1[1]) + (x1[2] * x1[2] + x1[3] * x1[3]);
                        const f32x4 hv = x1 * gv[bj][n]; v2u w; w.x = cvt_pk_bf16(hv[0], hv[1]); w.y = cvt_pk_bf16(hv[2], hv[3]); *(v2u*)(H2 + off + bj * HALF + n * 16) = w; }
                ss += __shfl_xor(ss, 16); ss += __shfl_xor(ss, 32);
                if (fq == 0) RSC[wc * 256 + lr] = ss; }
            asm volatile("" ::: "memory");
        }
        PG8_EBAR();
        const int tid = wid * 64 + lane;
        if (tid < 256) RS[(size_t)u.pn * M + r0 + tid] = (RSC[tid] + RSC[256 + tid]) + (RSC[512 + tid] + RSC[768 + tid]);
        PG8_EBAR();
    } };
__device__ __forceinline__ float dpp_ror1(float x) { return __builtin_bit_cast(float, __builtin_amdgcn_update_dpp(0, __builtin_bit_cast(int, x), 0x121, 0xf, 0xf, false)); }
__device__ __forceinline__ float dpp_ror15(float x) { return __builtin_bit_cast(float, __builtin_amdgcn_update_dpp(0, __builtin_bit_cast(int, x), 0x12f, 0xf, 0xf, false)); }
__device__ __forceinline__ float silu_mul(float g, float v) { return g * __builtin_amdgcn_rcpf(1.0f + __builtin_amdgcn_exp2f(-1.4426950408889634f * g)) * v; }
struct FEpiUp { static constexpr bool PERM = true, BARRIERS = true; bf16* ACT; const float* RS; const float* conv_w; const float* conv_b; float* EU; float* EC;
    __device__ __forceinline__ void run(Acc& acc, const Unit& u, int wr, int wc, int fr, int fq, LAS unsigned char* ldsx, int wid, int lane) const {
        const int r0 = u.pm * BM;
        LAS float* EDGE = (LAS float*)ldsx;
#pragma unroll
        for (int ai = 0; ai < 2; ++ai)
#pragma unroll
            for (int m = 0; m < 4; ++m) { const size_t row = r0 + ai * HALF + wr * 64 + m * 16 + fr;
                const float ss = (RS[row] + RS[(size_t)M + row]) + (RS[(size_t)2 * M + row] + RS[(size_t)3 * M + row]); const float rs = 1.0f / sqrtf(ss * (1.f / DM) + EPS);
#pragma unroll
                for (int bj = 0; bj < 2; ++bj)
#pragma unroll
                    for (int n = 0; n < 2; ++n) acc[ai][bj][m][n] *= rs;
                if (m & 1) asm volatile("" ::: "memory"); }
        const int lcol = wc * 32 + 8 * fq;
        if (fr == 0) {
#pragma unroll
            for (int ai = 0; ai < 2; ++ai)
#pragma unroll
                for (int bj = 0; bj < 2; ++bj)
#pragma unroll
                    for (int n = 0; n < 2; ++n) *(LAS f32x4*)(EDGE + ((2 * ai + wr) * 2 + 0) * 256 + bj * HALF + lcol + 4 * n) = acc[ai][bj][0][n]; }
        if (fr == 15) {
#pragma unroll
            for (int ai = 0; ai < 2; ++ai)
#pragma unroll
                for (int bj = 0; bj < 2; ++bj)
#pragma unroll
                    for (int n = 0; n < 2; ++n) *(LAS f32x4*)(EDGE + ((2 * ai + wr) * 2 + 1) * 256 + bj * HALF + lcol + 4 * n) = acc[ai][bj][3][n]; }
        PG8_EBAR();
        { const int tid = wid * 64 + lane; if (tid < 256) { EU[((size_t)u.pm * 2 + 0) * NUP + u.pn * 256 + tid] = EDGE[tid]; EU[((size_t)u.pm * 2 + 1) * NUP + u.pn * 256 + tid] = EDGE[7 * 256 + tid]; } }
        typedef float f32x2 __attribute__((ext_vector_type(2)));
        v2u pk0[2][4];
#pragma unroll
        for (int n = 0; n < 2; ++n) { const int fcol = u.pn * HALF + lcol + 4 * n;
            const f32x4 bg = *(const f32x4*)(conv_b + fcol), g0 = *(const f32x4*)(conv_w + fcol), g1 = *(const f32x4*)(conv_w + NUP + fcol), g2 = *(const f32x4*)(conv_w + 2 * NUP + fcol);
            const f32x4 bv = *(const f32x4*)(conv_b + DFF + fcol), v0 = *(const f32x4*)(conv_w + DFF + fcol), v1 = *(const f32x4*)(conv_w + NUP + DFF + fcol), v2 = *(const f32x4*)(conv_w + 2 * NUP + DFF + fcol);
#pragma unroll
            for (int ai = 0; ai < 2; ++ai) { const int s = 2 * ai + wr;
                v2u w[4];
#pragma unroll
                for (int ep = 0; ep < 2; ++ep) {
                    f32x2 eTg = {0.f, 0.f}, eTv = eTg, eBg = eTg, eBv = eTg;
                    if (s > 0) { eTg = *(const LAS f32x2*)(EDGE + ((s - 1) * 2 + 1) * 256 + lcol + 4 * n + 2 * ep); eTv = *(const LAS f32x2*)(EDGE + ((s - 1) * 2 + 1) * 256 + HALF + lcol + 4 * n + 2 * ep); }
                    if (s < 3) { eBg = *(const LAS f32x2*)(EDGE + ((s + 1) * 2 + 0) * 256 + lcol + 4 * n + 2 * ep); eBv = *(const LAS f32x2*)(EDGE + ((s + 1) * 2 + 0) * 256 + HALF + lcol + 4 * n + 2 * ep); }
                    float act[4][2];
#pragma unroll
                    for (int ee = 0; ee < 2; ++ee) { const int e = 2 * ep + ee;
                        float r1[4], r15[4], cg[4], cv[4];
#pragma unroll
                        for (int m = 0; m < 4; ++m) { r1[m] = dpp_ror1(acc[ai][0][m][n][e]); r15[m] = dpp_ror15(acc[ai][0][m][n][e]); }
#pragma unroll
                        for (int m = 0; m < 4; ++m) { const float up = fr == 0 ? (m == 0 ? eTg[ee] : r1[m == 0 ? 0 : m - 1]) : r1[m]; const float dn = fr == 15 ? (m == 3 ? eBg[ee] : r15[m == 3 ? 3 : m + 1]) : r15[m];
                            cg[m] = bg[e] + g0[e] * up + g1[e] * acc[ai][0][m][n][e] + g2[e] * dn; }
#pragma unroll
                        for (int m = 0; m < 4; ++m) { r1[m] = dpp_ror1(acc[ai][1][m][n][e]); r15[m] = dpp_ror15(acc[ai][1][m][n][e]); }
#pragma unroll
                        for (int m = 0; m < 4; ++m) { const float up = fr == 0 ? (m == 0 ? eTv[ee] : r1[m == 0 ? 0 : m - 1]) : r1[m]; const float dn = fr == 15 ? (m == 3 ? eBv[ee] : r15[m == 3 ? 3 : m + 1]) : r15[m];
                            cv[m] = bv[e] + v0[e] * up + v1[e] * acc[ai][1][m][n][e] + v2[e] * dn; }
                        if (ai == 0 && wr == 0 && fr == 0) { float* p = EC + ((size_t)u.pm * 2 + 0) * NUP + u.pn * 256 + lcol + 4 * n + e; p[0] = cg[0]; p[HALF] = cv[0]; }
                        if (ai == 1 && wr == 1 && fr == 15) { float* p = EC + ((size_t)u.pm * 2 + 1) * NUP + u.pn * 256 + lcol + 4 * n + e; p[0] = cg[3]; p[HALF] = cv[3]; }
#pragma unroll
                        for (int m = 0; m < 4; ++m) act[m][ee] = silu_mul(cg[m], cv[m]);
                    }
#pragma unroll
                    for (int m = 0; m < 4; ++m) { const unsigned pw = cvt_pk_bf16(act[m][0], act[m][1]); if (ep == 0) w[m].x = pw; else w[m].y = pw; }
                }
#pragma unroll
                for (int m = 0; m < 4; ++m) {
                    if (n == 0) pk0[ai][m] = w[m];
                    else { v4u o; o.x = pk0[ai][m].x; o.y = pk0[ai][m].y; o.z = w[m].x; o.w = w[m].y;
                        *(v4u*)(ACT + (size_t)(r0 + ai * HALF + wr * 64 + m * 16 + fr) * DFF + u.pn * HALF + lcol) = o; } }
            } }
    } };
struct FEpiDown { static constexpr bool PERM = false, BARRIERS = false; float* out;
    __device__ __forceinline__ void operator()(const Acc& acc, const Unit& u, int wr, int wc, int fr, int fq) const {
        const int col0 = u.pn * BM + wc * 32 + 4 * fq;
#pragma unroll
        for (int ai = 0; ai < 2; ++ai) {
            f32x4 xv[4][2][2];
#pragma unroll
            for (int m = 0; m < 4; ++m) { const size_t off = (size_t)(u.pm * BM + ai * HALF + wr * 64 + m * 16 + fr) * DM + col0;
#pragma unroll
                for (int bj = 0; bj < 2; ++bj)
#pragma unroll
                    for (int n = 0; n < 2; ++n) xv[m][bj][n] = *(const f32x4*)(out + off + bj * HALF + n * 16); }
#pragma unroll
            for (int m = 0; m < 4; ++m) { const size_t off = (size_t)(u.pm * BM + ai * HALF + wr * 64 + m * 16 + fr) * DM + col0;
#pragma unroll
                for (int bj = 0; bj < 2; ++bj)
#pragma unroll
                    for (int n = 0; n < 2; ++n) *(f32x4*)(out + off + bj * HALF + n * 16) = xv[m][bj][n] + acc[ai][bj][m][n]; }
            asm volatile("" ::: "memory");
        } } };

template <class Epi, class Sched>
__device__ __forceinline__ void gemm_phase(LAS unsigned char* lds, LAS unsigned char* ldsx, const Gemm g, const Sched& S, const Epi& E, const int wid) {
    const int lane = lane_id_fresh(), tid = wid * 64 + lane;
    const int  wr = wid >> 2, wc = wid & 3, fr = lane & 15, fq = lane >> 4;
    const int K = g.K, nt = K / BK, lda = g.lda;
    unsigned voffA[2], voffB[2];
#pragma unroll
    for (int i = 0; i < 2; ++i) { int R, C; stage_rc(tid * 16 + i * 8192, R, C); const int Rb = Epi::PERM ? ((R & ~31) + perm32(R & 31)) : R;
        voffA[i] = (unsigned)(R * lda + C) * 2u; voffB[i] = (unsigned)(Rb * K + C) * 2u; }
    const size_t kstep = (size_t)(BK * 2);
    const size_t hstepA = (size_t)HALF * lda * 2, hstepB = (size_t)HALF * K * 2;
    const size_t tstepA = 2 * hstepA, tstepB = 2 * hstepB;
    const unsigned ldsw = (unsigned)wid * 1024u;
    const int aoff = lds_byte(wr * 64 + fr, fq * 8), boff = lds_byte(wc * 32 + fr, fq * 8);
#define PG8_SA(b, h) (((b) * 2 + (h)) * HTB)
#define PG8_SB(b, h) ((4 + (b) * 2 + (h)) * HTB)
#define PG8_STAGE(bufoff, gbase, voff) do { _Pragma("unroll") for (int _i = 0; _i < 2; ++_i) \
        __builtin_amdgcn_global_load_lds((const unsigned*)((const char*)(gbase) + (voff)[_i]), (LAS unsigned*)(lds + (bufoff) + ldsw + _i * 8192), 16, 0, 0); } while (0)
#define PG8_LDA(dst, b, h) do { _Pragma("unroll") for (int m = 0; m < 4; ++m) _Pragma("unroll") for (int k = 0; k < 2; ++k) dst[m][k] = *(const LAS bf16x8*)(lds + PG8_SA(b, h) + aoff + m * 2048 + k * 1024); } while (0)
#define PG8_LDB(dst, b, h) do { _Pragma("unroll") for (int n = 0; n < 2; ++n) _Pragma("unroll") for (int k = 0; k < 2; ++k) dst[n][k] = *(const LAS bf16x8*)(lds + PG8_SB(b, h) + boff + n * 2048 + k * 1024); } while (0)
#define PG8_MMA(ai, bj, At, Bt) do { __builtin_amdgcn_s_setprio(1); _Pragma("unroll") for (int m = 0; m < 4; ++m) _Pragma("unroll") for (int n = 0; n < 2; ++n) _Pragma("unroll") for (int k = 0; k < 2; ++k) \
        acc[ai][bj][m][n] = __builtin_amdgcn_mfma_f32_16x16x32_bf16(Bt[n][k], At[m][k], acc[ai][bj][m][n], 0, 0, 0); __builtin_amdgcn_s_setprio(0); } while (0)
#define PG8_WAIT_V(n) asm volatile("s_waitcnt vmcnt(" #n ")" ::: "memory")
#define PG8_WAIT_L(n) asm volatile("s_waitcnt lgkmcnt(" #n ")" ::: "memory")
#define PG8_BAR __builtin_amdgcn_s_barrier()
#define PG8_SCHED __builtin_amdgcn_sched_barrier(0)
    Unit cur, nxt; int ui = 0;
    if (!S.next(0, cur)) return;
    Acc acc;
#pragma unroll
    for (int a = 0; a < 2; ++a)
#pragma unroll
        for (int b = 0; b < 2; ++b)
#pragma unroll
            for (int m = 0; m < 4; ++m)
#pragma unroll
                for (int n = 0; n < 2; ++n) acc[a][b][m][n] = (f32x4){0.f, 0.f, 0.f, 0.f};
    bf16x8 At[4][2], B0[2][2], B1[2][2];
    const char* cA = (const char*)g.A + (size_t)cur.pm * tstepA + (size_t)cur.pn * g.a_pn_off * 2; const char* cB = (const char*)g.Bt + (size_t)cur.pn * tstepB;
    PG8_STAGE(PG8_SB(0, 0), cB, voffB); PG8_STAGE(PG8_SB(0, 1), cB + hstepB, voffB); PG8_STAGE(PG8_SA(0, 0), cA, voffA); PG8_STAGE(PG8_SA(0, 1), cA + hstepA, voffA);
    if (wr == 1) PG8_BAR;
    PG8_WAIT_V(2); PG8_BAR;
    PG8_STAGE(PG8_SB(1, 0), cB + kstep, voffB); PG8_STAGE(PG8_SA(1, 0), cA + kstep, voffA); PG8_STAGE(PG8_SB(1, 1), cB + hstepB + kstep, voffB);
    PG8_WAIT_V(6); PG8_BAR;
    for (;;) {
        const bool has_next = S.next(ui + 1, nxt);
        const char* nA = has_next ? (const char*)g.A + (size_t)nxt.pm * tstepA + (size_t)nxt.pn * g.a_pn_off * 2 : cA; const char* nB = has_next ? (const char*)g.Bt + (size_t)nxt.pn * tstepB : cB;
        for (int t = 0; t < nt; t += 2) {
            const bool last = (t == nt - 2);
            const char* a1 = cA + (size_t)(t + 1) * kstep;
            const char* a2 = last ? nA : cA + (size_t)(t + 2) * kstep; const char* b2 = last ? nB : cB + (size_t)(t + 2) * kstep;
            const char* a3 = a2 + kstep; const char* b3 = b2 + kstep;
            PG8_LDB(B0, 0, 0); PG8_LDB(B1, 0, 1); PG8_SCHED; PG8_LDA(At, 0, 0); PG8_STAGE(PG8_SA(1, 1), a1 + hstepA, voffA);
            PG8_WAIT_V(8); PG8_WAIT_L(0); PG8_BAR; PG8_MMA(0, 0, At, B0); PG8_MMA(0, 1, At, B1); PG8_BAR; PG8_SCHED;
            PG8_LDA(At, 0, 1); PG8_STAGE(PG8_SB(0, 0), b2, voffB); PG8_STAGE(PG8_SB(0, 1), b2 + hstepB, voffB); PG8_STAGE(PG8_SA(0, 0), a2, voffA);
            PG8_WAIT_V(8); PG8_WAIT_L(0); PG8_BAR; PG8_MMA(1, 0, At, B0); PG8_MMA(1, 1, At, B1); PG8_BAR; PG8_SCHED;
            PG8_LDB(B0, 1, 0); PG8_LDB(B1, 1, 1); PG8_SCHED; PG8_LDA(At, 1, 0); PG8_STAGE(PG8_SA(0, 1), a2 + hstepA, voffA);
            PG8_WAIT_V(8); PG8_WAIT_L(0); PG8_BAR; PG8_MMA(0, 0, At, B0); PG8_MMA(0, 1, At, B1); PG8_BAR; PG8_SCHED;
            PG8_LDA(At, 1, 1); PG8_STAGE(PG8_SB(1, 0), b3, voffB); PG8_STAGE(PG8_SB(1, 1), b3 + hstepB, voffB); PG8_STAGE(PG8_SA(1, 0), a3, voffA);
            PG8_WAIT_V(8); PG8_WAIT_L(0); PG8_BAR; PG8_MMA(1, 0, At, B0); PG8_MMA(1, 1, At, B1); PG8_BAR; PG8_SCHED;
        }
        if (wr == 0) PG8_BAR;
        { const int lane_ = lane_id_fresh(), fr_ = lane_ & 15, fq_ = lane_ >> 4;
          if constexpr (Epi::BARRIERS) E.run(acc, cur, wr, wc, fr_, fq_, ldsx, wid, lane_); else E(acc, cur, wr, wc, fr_, fq_); }
        if (!has_next) break;
#pragma unroll
        for (int a = 0; a < 2; ++a)
#pragma unroll
            for (int b = 0; b < 2; ++b)
#pragma unroll
                for (int m = 0; m < 4; ++m)
#pragma unroll
                    for (int n = 0; n < 2; ++n) acc[a][b][m][n] = (f32x4){0.f, 0.f, 0.f, 0.f};
        cur = nxt; cA = nA; cB = nB; ++ui;
        if (wr == 1) PG8_BAR;
    }
    PG8_WAIT_V(0);
    PG8_BAR;
#undef PG8_SA
#undef PG8_SB
#undef PG8_STAGE
#undef PG8_LDA
#undef PG8_LDB
#undef PG8_MMA
#undef PG8_WAIT_V
#undef PG8_WAIT_L
#undef PG8_BAR
#undef PG8_SCHED
}
}

__device__ __forceinline__ void up_fixup(const Frame& F, const float* EU, const float* EC) {
    const int gt = F.gw * 64 + F.lane, ngt = F.ngw * 64;
    for (int idx = gt; idx < (M / 256) * DFF; idx += ngt) { const int pm = idx / DFF, f = idx - pm * DFF;
        int t0, S, base; seqpos(pm * 256, t0, S, base); if (t0 == 0) continue;
        const int cgc = (f >> 7) * 256 + (f & 127), cvc = cgc + 128;
        const float* euP = EU + ((size_t)(pm - 1) * 2 + 1) * NUP; const float* euN = EU + ((size_t)pm * 2 + 0) * NUP;
        const float* ecP = EC + ((size_t)(pm - 1) * 2 + 1) * NUP; const float* ecN = EC + ((size_t)pm * 2 + 0) * NUP;
        { const float cg = ecN[cgc] + F.conv_w[f] * euP[cgc], cv = ecN[cvc] + F.conv_w[DFF + f] * euP[cvc];
          F.ACT[(size_t)(pm * 256) * DFF + f] = (bf16)f2bf(pg8::silu_mul(cg, cv)); }
        { const float cg = ecP[cgc] + F.conv_w[2 * NUP + f] * euN[cgc], cv = ecP[cvc] + F.conv_w[2 * NUP + DFF + f] * euN[cvc];
          F.ACT[(size_t)(pm * 256 - 1) * DFF + f] = (bf16)f2bf(pg8::silu_mul(cg, cv)); }
    }
}
namespace att {
constexpr int KSLOT = 12288, VSLOT = 8192, NSLOT = 3;
constexpr int L_K = 0, L_V = NSLOT * KSLOT, L_WS = L_V + NSLOT * VSLOT, L_OST = L_WS + NWAVES * 256, L_END = L_OST + NWAVES * 4096;
typedef short s16x4 __attribute__((ext_vector_type(4)));
typedef short v4i16_t __attribute__((ext_vector_type(4)));
__device__ __forceinline__ void glds16(const void* gsrc, unsigned lds_dst) { unsigned keep;
    asm volatile("s_mov_b32 %0, m0\n\ts_mov_b32 m0, %2\n\ts_nop 0\n\tglobal_load_lds_dwordx4 %1, off\n\ts_mov_b32 m0, %0" : "=&s"(keep) : "v"(gsrc), "s"(lds_dst) : "memory"); }
__device__ __forceinline__ s16x4 vtr(const LAS unsigned char* p) { return __builtin_bit_cast(s16x4, __builtin_amdgcn_ds_read_tr16_b64_v4i16((LAS v4i16_t*)p)); }
#define ATT_WAIT_BAR(N) asm volatile("s_waitcnt vmcnt(" #N ") lgkmcnt(0)\n\ts_barrier" ::: "memory")
#define ATT_RFL(x) ((unsigned)__builtin_amdgcn_readfirstlane((int)(x)))

template <int THRL>
__device__ __forceinline__ void attn_unit(const bf16* Q, const bf16* K, const bf16* V, bf16* MIX, int q0, int base, int S, int h, LAS unsigned char* shm, int wid, int lane) {
    const int r32 = lane & 31, hi = lane >> 5;
    const unsigned lds0 = (unsigned)(uintptr_t)shm;
    LAS float* wsf = (LAS float*)(shm + L_WS) + wid * 64;
    constexpr size_t KT = (size_t)NH * 12 * 512, VT = (size_t)NH * 2 * 2048;
    const bf16* ksrc = K + ((size_t)((base >> 6) * NH + h) * 12) * 512 + lane * 8;
    const bf16* vsrc = V + ((size_t)((base >> 6) * NH + h) * 2) * 2048 + lane * 8;
#define ATT_DMA(t, slot) do { glds16(ksrc + (size_t)(t) * KT + wid * 512, ATT_RFL(lds0 + L_K + (slot) * KSLOT + wid * 1024)); \
        if (wid < 4) glds16(ksrc + (size_t)(t) * KT + (wid + 8) * 512, ATT_RFL(lds0 + L_K + (slot) * KSLOT + (wid + 8) * 1024)); \
        glds16(vsrc + (size_t)(t) * VT + wid * 512, ATT_RFL(lds0 + L_V + (slot) * VSLOT + wid * 1024)); } while (0)
    bf16x8 qf[6];
#pragma unroll
    for (int s = 0; s < 6; ++s) qf[s] = *(const bf16x8*)(Q + (size_t)(q0 + wid * 32 + r32) * NQ + h * QKD + 16 * s + 8 * hi);
    const int NT = S >> 6;
    ATT_DMA(0, 0); ATT_DMA(1, 1);
    f32x16 o0 = {}, o1 = {};
    float mrun = -1e30f, lrun = 0.f;
    int slot = 0;
    for (int t = 0; t < NT; ++t) {
        if (t + 1 < NT) { if (wid < 4) ATT_WAIT_BAR(3); else ATT_WAIT_BAR(2); } else ATT_WAIT_BAR(0);
        if (t + 2 < NT) { const int s2 = slot == 0 ? 2 : slot - 1; ATT_DMA(t + 2, s2); }
        f32x16 p0 = {}, p1 = {};
        { const LAS unsigned char* kp = shm + L_K + slot * KSLOT + hi * 1024 + r32 * 16;
#pragma unroll
          for (int s = 0; s < 6; ++s) { const bf16x8 a0 = *(const LAS bf16x8*)(kp + s * 2048), a1 = *(const LAS bf16x8*)(kp + s * 2048 + 512);
              p0 = __builtin_amdgcn_mfma_f32_32x32x16_bf16(a0, qf[s], p0, 0, 0, 0); p1 = __builtin_amdgcn_mfma_f32_32x32x16_bf16(a1, qf[s], p1, 0, 0, 0); } }
        float mx = fmaxf(p0[0], p1[0]);
#pragma unroll
        for (int r = 1; r < 16; ++r) mx = fmaxf(mx, fmaxf(p0[r], p1[r]));
        mx = fmaxf(mx, __shfl_xor(mx, 32));
        if (__any(mx > mrun + (float)THRL)) {
            const float mnew = fmaxf(mrun, mx), alpha = __builtin_amdgcn_exp2f(mrun - mnew);
            lrun *= alpha; mrun = mnew;
            if (hi == 0) wsf[r32] = alpha;
            asm volatile("s_waitcnt lgkmcnt(0)" ::: "memory");
#pragma unroll
            for (int r = 0; r < 16; ++r) { const float a = wsf[crow(r, hi)]; o0[r] *= a; o1[r] *= a; }
            asm volatile("s_waitcnt lgkmcnt(0)" ::: "memory");
        }
        float ls = 0.f;
#pragma unroll
        for (int r = 0; r < 16; ++r) { p0[r] = __builtin_amdgcn_exp2f(p0[r] - mrun); p1[r] = __builtin_amdgcn_exp2f(p1[r] - mrun); ls += p0[r] + p1[r]; }
        lrun += ls;
        bf16x8 pa[4];
#pragma unroll
        for (int ks = 0; ks < 4; ++ks) { v4u w;
            if (ks < 2) { w.x = pg8::cvt_pk_bf16(p0[8 * ks + 0], p0[8 * ks + 1]); w.y = pg8::cvt_pk_bf16(p0[8 * ks + 2], p0[8 * ks + 3]); w.z = pg8::cvt_pk_bf16(p0[8 * ks + 4], p0[8 * ks + 5]); w.w = pg8::cvt_pk_bf16(p0[8 * ks + 6], p0[8 * ks + 7]); }
            else { const int b = 8 * (ks - 2); w.x = pg8::cvt_pk_bf16(p1[b + 0], p1[b + 1]); w.y = pg8::cvt_pk_bf16(p1[b + 2], p1[b + 3]); w.z = pg8::cvt_pk_bf16(p1[b + 4], p1[b + 5]); w.w = pg8::cvt_pk_bf16(p1[b + 6], p1[b + 7]); }
            pa[ks] = __builtin_bit_cast(bf16x8, w); }
        { const LAS unsigned char* vp = shm + L_V + slot * VSLOT + ((lane >> 4) & 1) * 32 + (lane & 3) * 8 + (4 * hi + ((lane & 15) >> 2)) * 64;
#pragma unroll
          for (int ks = 0; ks < 4; ++ks) {
              const s16x4 l0 = vtr(vp + ks * 1024), h0 = vtr(vp + ks * 1024 + 512), l1 = vtr(vp + 4096 + ks * 1024), h1 = vtr(vp + 4096 + ks * 1024 + 512);
              const bf16x8 vf0 = (bf16x8){l0[0], l0[1], l0[2], l0[3], h0[0], h0[1], h0[2], h0[3]}, vf1 = (bf16x8){l1[0], l1[1], l1[2], l1[3], h1[0], h1[1], h1[2], h1[3]};
              o0 = __builtin_amdgcn_mfma_f32_32x32x16_bf16(pa[ks], vf0, o0, 0, 0, 0); o1 = __builtin_amdgcn_mfma_f32_32x32x16_bf16(pa[ks], vf1, o1, 0, 0, 0); } }
        slot = slot == 2 ? 0 : slot + 1;
    }
    lrun += __shfl_xor(lrun, 32);
    if (hi == 0) wsf[r32] = 1.0f / lrun;
    asm volatile("s_waitcnt lgkmcnt(0)" ::: "memory");
    { LAS bf16* stg = (LAS bf16*)(shm + L_OST) + wid * 2048;
#pragma unroll
      for (int r = 0; r < 16; ++r) { const int orow = crow(r, hi); const float li = wsf[orow];
          stg[orow * 64 + r32] = (bf16)f2bf(o0[r] * li); stg[orow * 64 + 32 + r32] = (bf16)f2bf(o1[r] * li); }
      asm volatile("s_waitcnt lgkmcnt(0)" ::: "memory");
#pragma unroll
      for (int i = 0; i < 4; ++i) { const int row = i * 8 + (lane >> 3), ch = lane & 7; const v4u v = *(const LAS v4u*)(stg + row * 64 + ch * 8);
          *(v4u*)(MIX + (size_t)(q0 + wid * 32 + row) * DM + 512 + h * VD + ch * 8) = v; } }
    asm volatile("s_waitcnt lgkmcnt(0)\n\ts_barrier" ::: "memory");
#undef ATT_DMA
}
__device__ __forceinline__ void attn_phase(const Frame& F) {
    for (int u = blockIdx.x; u < 1536; u += F.G) {
        const int round = u >> 8, c = u & 255, x = c & 7, j = c >> 3;
        int q0, base, S, h;
        if (round < 2) { const int pair = 2 * x + round; S = SS; base = MP + (pair >> 3) * SS; h = pair & 7; q0 = base + j * 256; }
        else { const int pair = x * 16 + (round - 2) * 4 + (j >> 3); S = SP; base = (pair >> 3) * SP; h = pair & 7; q0 = base + (j & 7) * 256; }
        attn_unit<8>(F.Q, F.K, F.V, F.MIX, q0, base, S, h, F.lds, F.wave, F.lane);
    }
}
}

constexpr int N_PHASES = 11;
__global__ void __launch_bounds__(NWAVES * 64, 2) mega_fwd(Args args) {
    extern __shared__ __attribute__((aligned(16))) unsigned char lds[];
    LAS unsigned char* const ldsb = (LAS unsigned char*)lds;
    const int wave0 = __builtin_amdgcn_readfirstlane((int)threadIdx.x >> 6); const int tid0 = wave0 * 64 + lane_id_fresh();
    unsigned char* ws = args.ws;
    volatile LAS unsigned* MISC = (volatile LAS unsigned*)(ldsb + MISC_OFF);
    for (int u = tid0; u < (LDS_BYTES - MISC_OFF) / 4; u += NWAVES * 64) ((LAS unsigned*)(ldsb + MISC_OFF))[u] = 0u;
    __syncthreads();
    const int lo = args.ph_lo, hi = args.ph_hi;
    XcdBarrier bar; bar.bar = (unsigned*)(ws + WS_CTL) + CW_BAR; bar.x = 0; bar.st = nullptr;
    if (hi - lo > 1) bar = xcd_barrier_post((unsigned*)(ws + WS_CTL) + CW_BAR, MISC + 8, wave0);
#define IN(k) (lo <= (k) && (k) < hi)
#define SEAM(k) do { if (IN(k) && IN((k) + 1)) xcd_barrier(bar, wave0); } while (0)

    LAS unsigned char* const ldsx = ldsb + 131072;
    if (IN(0)) { const Frame F = make_frame(ldsb, wave0); p0_prologue(F); } SEAM(0);
    if (IN(1)) { const Frame F = make_frame(ldsb, wave0);
#if FAST_G1
        pg8::Gemm g{F.HB, F.Win_t, DM, 0, M, NZ, DM}; pg8::StaticOrder S; S.init(M, NZ, F.G, (int)blockIdx.x); pg8::FEpiZ E{F.Z};
        pg8::gemm_phase(F.lds, ldsx, g, S, E, wave0);
#else
        EpiZ E{F.Z}; sgemm(F, F.HB, DM, 0, F.Win_t, DM, M, NZ, E);
#endif
    } SEAM(1);
    if (IN(2)) { const Frame F = make_frame(ldsb, wave0); p2_rows(F); } SEAM(2);
    if (IN(3)) { const Frame F = make_frame(ldsb, wave0);
#if FAST_G2
        { pg8::Gemm g{F.QN, F.Wuq_t, 256, 0, M, NQ, 256}; pg8::StaticOrder S; S.init(M, NQ, F.G, (int)blockIdx.x); pg8::FEpiQ E{F.Q, F.COS, F.SIN}; pg8::gemm_phase(F.lds, ldsx, g, S, E, wave0); }
        { pg8::Gemm g{F.KVN, F.Wukv_t, 128, 0, M, NKV, 128}; pg8::StaticOrder S; S.init(M, NKV, F.G, (int)blockIdx.x); pg8::FEpiKV E{F.K, F.V}; pg8::gemm_phase(F.lds, ldsx, g, S, E, wave0); }
        { pg8::Gemm g{F.POOLED, F.Wpool_t, 512, 256, M, 512, 256}; pg8::StaticOrder S; S.init(M, 512, F.G, (int)blockIdx.x); pg8::FEpiPool E{F.MIX, F.pool_scale}; pg8::gemm_phase(F.lds, ldsx, g, S, E, wave0); }
#else
        { EpiQ E{F.Q, F.COS, F.SIN}; sgemm(F, F.QN, 256, 0, F.Wuq_t, 256, M, NQ, E); }
        { EpiKV E{F.K, F.V}; sgemm(F, F.KVN, 128, 0, F.Wukv_t, 128, M, NKV, E); }
        { EpiPool E{F.MIX, F.pool_scale}; sgemm(F, F.POOLED, 512, 256, F.Wpool_t, 256, M, 512, E); }
#endif
    } SEAM(3);
    if (IN(4)) { const Frame F = make_frame(ldsb, wave0);
#if FAST_ATTN
        att::attn_phase(F);
#else
        attn_simple(F);
#endif
    } SEAM(4);
    if (IN(5)) { const Frame F = make_frame(ldsb, wave0);
#if FAST_WO
        pg8::Gemm g{F.MIX, F.Wout_t, DM, 0, M, DM, DM}; pg8::StaticOrder S; S.init(M, DM, F.G, (int)blockIdx.x); pg8::FEpiWo E{F.xp, F.xs, F.out, F.H2, F.g_ffn, F.RS};
        pg8::gemm_phase(F.lds, ldsx, g, S, E, wave0);
#else
        EpiWo E{F.xp, F.xs, F.out}; sgemm(F, F.MIX, DM, 0, F.Wout_t, DM, M, DM, E);
#endif
    } SEAM(5);
    if (IN(6)) { const Frame F = make_frame(ldsb, wave0);
#if !(FAST_WO && DEFER_NORM)
        for (int m = F.gw; m < M; m += F.ngw) rms_row_to_bf16(F, F.out + (size_t)m * DM, F.g_ffn, F.H2 + (size_t)m * DM);
#endif
    } SEAM(6);
    if (IN(7)) { const Frame F = make_frame(ldsb, wave0);
#if FAST_UP
        float* EU = (float*)F.HB; float* EC = EU + (size_t)(M / 256) * 2 * NUP;
        pg8::Gemm g{F.H2, F.Wup_t, DM, 0, M, NUP, DM}; pg8::StaticOrder S; S.init(M, NUP, F.G, (int)blockIdx.x); pg8::FEpiUp E{F.ACT, F.RS, F.conv_w, F.conv_b, EU, EC};
        pg8::gemm_phase(F.lds, ldsx, g, S, E, wave0);
#else
        up_simple(F);
#endif
    } SEAM(7);
    if (IN(8)) {
#if FAST_UP
        const Frame F = make_frame(ldsb, wave0); const float* EU = (const float*)F.HB; up_fixup(F, EU, EU + (size_t)(M / 256) * 2 * NUP);
#endif
    } SEAM(8);
    if (IN(9)) { const Frame F = make_frame(ldsb, wave0);
#if FAST_DOWN
        pg8::Gemm g{F.ACT, F.Wdown_t, DFF, 0, M, DM, DFF}; pg8::StaticOrder S; S.init(M, DM, F.G, (int)blockIdx.x); pg8::FEpiDown E{F.out};
        pg8::gemm_phase(F.lds, ldsx, g, S, E, wave0);
#else
        EpiDown E{F.out}; sgemm(F, F.ACT, DFF, 0, F.Wdown_t, DFF, M, DM, E);
#endif
    }
    SEAM(9);
    if (IN(10)) { const Frame F = make_frame(ldsb, wave0);
        for (int m = F.gw; m < M; m += F.ngw) {
            GAS f32x4* xr = (GAS f32x4*)(F.out + (size_t)m * DM) + F.lane; const GAS f32x4* gr = (const GAS f32x4*)F.g_final + F.lane;
            f32x4 v[4]; float s = 0.f;
#pragma unroll
            for (int j = 0; j < 4; ++j) { v[j] = xr[64 * j]; s += (v[j].x * v[j].x + v[j].y * v[j].y) + (v[j].z * v[j].z + v[j].w * v[j].w); }
            const float rstd = 1.0f / sqrtf(wave_sum(s) * (1.f / DM) + EPS);
#pragma unroll
            for (int j = 0; j < 4; ++j) xr[64 * j] = v[j] * rstd * gr[64 * j];
        }
    }
#undef IN
#undef SEAM
}

extern "C" void kernel_launch(void* const* d_in, const int* in_sizes, int n_in, void* d_out, int out_size, void* d_ws, size_t ws_size, hipStream_t stream) {
    static int grid = 0;
    if (grid == 0) {
        if (n_in != 17 || out_size != M * DM || ws_size < WS_END) { fprintf(stderr, "kernel_launch: unexpected shapes (n_in %d, out %d, ws %zu)\n", n_in, out_size, ws_size); grid = -1; return; }
        int dev = 0, cus = 0, per_cu = 0;
        if (hipGetDevice(&dev) != hipSuccess || hipDeviceGetAttribute(&cus, hipDeviceAttributeMultiprocessorCount, dev) != hipSuccess) { grid = -1; return; }
        if (hipFuncSetAttribute((const void*)mega_fwd, hipFuncAttributeMaxDynamicSharedMemorySize, LDS_BYTES) != hipSuccess) { fprintf(stderr, "kernel_launch: hipFuncSetAttribute failed\n"); grid = -1; return; }
        if (hipOccupancyMaxActiveBlocksPerMultiprocessor(&per_cu, (const void*)mega_fwd, NWAVES * 64, LDS_BYTES) != hipSuccess || per_cu < 1) { fprintf(stderr, "kernel_launch: occupancy query says %d\n", per_cu); per_cu = 1; }
        (void)hipGetLastError();
        grid = cus;
    }
    if (grid < 0) return;
    (void)hipMemsetAsync((char*)d_ws + WS_CTL, 0, CTL_ZERO_BYTES, stream);
    Args a{};
    for (int i = 0; i < 17; ++i) a.in[i] = (const float*)d_in[i];
    a.out = (float*)d_out; a.ws = (unsigned char*)d_ws;
    for (int i = 0; i < 16; ++i) a.freq_rev[i] = std::pow(10000.0, -(double)i / 16.0) / 6.283185307179586476925287;
#if MK_N_LAUNCHES == 1
    a.ph_lo = 0; a.ph_hi = N_PHASES;
    hipLaunchKernelGGL(mega_fwd, dim3(grid), dim3(NWAVES * 64), LDS_BYTES, stream, a);
#else
    for (int p = 0; p < N_PHASES; ++p) { a.ph_lo = p; a.ph_hi = p + 1; hipLaunchKernelGGL(mega_fwd, dim3(grid), dim3(NWAVES * 64), LDS_BYTES, stream, a); }
#endif
}
```
